# Optimizing an MI355X kernel written in HIP

```python
import jax, jax.numpy as jnp
from jax import lax
import numpy as np

D_MODEL = 1024
BATCH = 16
SEQ = 4096
DEPTH = 4

GRID_W = 64
CTX_LEN = 256
HEAD_DIM = 64
W_SC = D_MODEL // 4
W_NA = D_MODEL // 2
NA_HEADS = W_NA // HEAD_DIM
W_CF = D_MODEL // 4
D_MIX = W_SC + W_NA + W_CF
SC_K = 3
CF_K = 31
NA_ROWS = 8
NA_COLS = 16
NORM_EPS = 1e-6
LN_EPS = 1e-5
PROJ_SIZES = [W_SC] * 4 + [W_NA] * 4 + [W_CF] * 3
PROJ_SPLITS = [int(s) for s in np.cumsum(PROJ_SIZES)[:-1]]
D_PROJ = int(sum(PROJ_SIZES))

kernel_name = "hybrid_conv_natten_conformer_dit"


def rmsnorm(x, g):
    xf = x.astype(jnp.float32)
    y = xf * lax.rsqrt(jnp.mean(xf * xf, axis=-1, keepdims=True) + NORM_EPS)
    return (y * g.astype(jnp.float32)).astype(x.dtype)


def layernorm(x, g, b):
    xf = x.astype(jnp.float32)
    mu = jnp.mean(xf, axis=-1, keepdims=True)
    var = jnp.mean(jnp.square(xf - mu), axis=-1, keepdims=True)
    y = (xf - mu) * lax.rsqrt(var + LN_EPS)
    return (y * g.astype(jnp.float32) + b.astype(jnp.float32)).astype(x.dtype)


def dwconv(x, w):
    k = w.shape[0]
    return lax.conv_general_dilated(
        x, w[:, None, :].astype(x.dtype), window_strides=(1,),
        padding=[(k // 2, k // 2)], dimension_numbers=('NWC', 'WIO', 'NWC'),
        feature_group_count=x.shape[-1])


def short_conv_branch(z_h, z_b, z_c, z_g, w_conv):
    return z_b * dwconv(z_c * z_h, w_conv) * jax.nn.silu(z_g)


def conformer_branch(z_p, z_q, z_g, w_conv, b_conv, ln_g, ln_b):
    u = z_p * jax.nn.sigmoid(z_q)
    u = dwconv(u, w_conv) + b_conv.astype(u.dtype)
    u = layernorm(u, ln_g, ln_b)
    return jax.nn.silu(u) * jax.nn.silu(z_g)


def heads(t):
    b, l, _ = t.shape
    return t.reshape(b, l, NA_HEADS, HEAD_DIM)


def neighbourhood_attention(q, k, v, kc, vc, rpb):
    b, l, h, dh = q.shape
    rows = l // GRID_W
    kr = min(NA_ROWS, rows)
    scale = HEAD_DIM ** -0.5
    qg = q.reshape(b, rows, GRID_W, h, dh)
    kg = k.reshape(b, rows, GRID_W, h, dh)
    vg = v.reshape(b, rows, GRID_W, h, dh)
    cols = jnp.arange(GRID_W)
    col_start = jnp.clip(cols - NA_COLS // 2, 0, GRID_W - NA_COLS)
    col_idx = col_start[:, None] + jnp.arange(NA_COLS)[None, :]
    col_bias_idx = col_idx - cols[:, None] + (NA_COLS - 1)
    rpb_cols = rpb[:, :, col_bias_idx]

    def row_block(r):
        rs = jnp.clip(r - kr // 2, 0, rows - kr)
        kb = lax.dynamic_slice_in_dim(kg, rs, kr, axis=1)
        vb = lax.dynamic_slice_in_dim(vg, rs, kr, axis=1)
        qr = lax.dynamic_index_in_dim(qg, r, axis=1, keepdims=False)
        kw = kb[:, :, col_idx]
        vw = vb[:, :, col_idx]
        row_bias_idx = rs + jnp.arange(kr) - r + (NA_ROWS - 1)
        bias = jnp.take(rpb_cols, row_bias_idx, axis=1)
        bias = bias.transpose(0, 2, 1, 3).astype(jnp.float32)
        s_win = jnp.einsum('bqhd,brqchd->bhqrc', qr, kw).astype(jnp.float32) * scale + bias[None]
        s_ctx = jnp.einsum('bqhd,bkhd->bhqk', qr, kc).astype(jnp.float32) * scale
        s = jnp.concatenate([s_win.reshape(b, h, GRID_W, kr * NA_COLS), s_ctx], axis=-1)
        p = jax.nn.softmax(s, axis=-1).astype(v.dtype)
        pw = p[..., :kr * NA_COLS].reshape(b, h, GRID_W, kr, NA_COLS)
        pc = p[..., kr * NA_COLS:]
        return (jnp.einsum('bhqrc,brqchd->bqhd', pw, vw)
                + jnp.einsum('bhqk,bkhd->bqhd', pc, vc))

    out = lax.map(row_block, jnp.arange(rows))
    return out.transpose(1, 0, 2, 3, 4).reshape(b, l, h * dh)


def context_attention(q, k, v):
    b, n, h, dh = q.shape
    s = jnp.einsum('bqhd,bkhd->bhqk', q, k).astype(jnp.float32) * (HEAD_DIM ** -0.5)
    p = jax.nn.softmax(s, axis=-1).astype(v.dtype)
    return jnp.einsum('bhqk,bkhd->bqhd', p, v).reshape(b, n, h * dh)


def setup_inputs(seed: int = 0) -> dict:
    key = jax.random.key(seed)
    ks = jax.random.split(key, 16)
    f32 = jnp.float32
    nrm = lambda k, shape, s: (jax.random.normal(k, shape, f32) * s).astype(f32)
    return {
        "x": nrm(ks[0], (BATCH, SEQ, D_MODEL), 1.0),
        "c": nrm(ks[1], (BATCH, D_MODEL), 1.0),
        "ctx": nrm(ks[2], (BATCH, CTX_LEN, D_MODEL), 1.0),
        "c_ctx": nrm(ks[3], (D_MODEL,), 1.0),
        "norm_g": 1.0 + nrm(ks[4], (DEPTH, D_MODEL), 0.02),
        "w_ada": nrm(ks[5], (DEPTH, D_MODEL, 3 * D_MODEL), 0.5 * D_MODEL ** -0.5),
        "b_ada": nrm(ks[6], (DEPTH, 3 * D_MODEL), 0.02),
        "w_in": nrm(ks[7], (DEPTH, D_MODEL, D_PROJ), D_MODEL ** -0.5),
        "conv_sc": nrm(ks[8], (DEPTH, SC_K, W_SC), SC_K ** -0.5),
        "rpb": nrm(ks[9], (DEPTH, NA_HEADS, 2 * NA_ROWS - 1, 2 * NA_COLS - 1), 0.1),
        "conv_cf": nrm(ks[10], (DEPTH, CF_K, W_CF), CF_K ** -0.5),
        "conv_cf_b": nrm(ks[11], (DEPTH, W_CF), 0.02),
        "ln_cf_g": 1.0 + nrm(ks[12], (DEPTH, W_CF), 0.02),
        "ln_cf_b": nrm(ks[13], (DEPTH, W_CF), 0.02),
        "w_out": nrm(ks[14], (DEPTH, D_MIX, D_MODEL), D_MIX ** -0.5),
        "final_g": 1.0 + nrm(ks[15], (D_MODEL,), 0.02),
    }


def reference(x, c, ctx, c_ctx, norm_g, w_ada, b_ada, w_in, conv_sc, rpb,
              conv_cf, conv_cf_b, ln_cf_g, ln_cf_b, w_out, final_g):
    for l in range(DEPTH):
        last = l == DEPTH - 1
        mod = jax.nn.silu(c) @ w_ada[l] + b_ada[l]
        shift, scale, gate = jnp.split(mod, 3, axis=-1)
        mod_c = jax.nn.silu(c_ctx) @ w_ada[l] + b_ada[l]
        shift_c, scale_c, gate_c = jnp.split(mod_c, 3, axis=-1)

        hl = rmsnorm(x, norm_g[l]) * (1.0 + scale[:, None, :]) + shift[:, None, :]
        hc = rmsnorm(ctx, norm_g[l]) * (1.0 + scale_c) + shift_c

        zl = jnp.split(hl @ w_in[l], PROJ_SPLITS, axis=-1)
        zc = jnp.split(hc @ w_in[l], PROJ_SPLITS, axis=-1)
        kc, vc = heads(zc[5]), heads(zc[6])

        ya = short_conv_branch(zl[0], zl[1], zl[2], zl[3], conv_sc[l])
        yb = neighbourhood_attention(heads(zl[4]), heads(zl[5]), heads(zl[6]), kc, vc, rpb[l])
        yb = yb * jax.nn.silu(zl[7])
        yc = conformer_branch(zl[8], zl[9], zl[10], conv_cf[l], conv_cf_b[l], ln_cf_g[l], ln_cf_b[l])
        y = jnp.concatenate([ya, yb, yc], axis=-1) @ w_out[l]

        if not last:
            ca = short_conv_branch(zc[0], zc[1], zc[2], zc[3], conv_sc[l])
            cb = context_attention(heads(zc[4]), kc, vc) * jax.nn.silu(zc[7])
            cc = conformer_branch(zc[8], zc[9], zc[10], conv_cf[l], conv_cf_b[l], ln_cf_g[l], ln_cf_b[l])
            yctx = jnp.concatenate([ca, cb, cc], axis=-1) @ w_out[l]
            ctx = ctx + gate_c * yctx

        x = x + gate[:, None, :] * y
    return rmsnorm(x, final_g)
```

```cpp
#include <hip/hip_runtime.h>
#include <hip/hip_cooperative_groups.h>
#include <cstdio>
namespace cg = cooperative_groups;

#ifndef PROBE
#define PROBE 0
#endif
#ifndef MK_COOP
#define MK_COOP 1
#endif

typedef unsigned short u16;
using bf16x8 = __attribute__((ext_vector_type(8))) short;
using s16x4  = __attribute__((ext_vector_type(4))) short;
using f32x4  = __attribute__((ext_vector_type(4))) float;
using u32x4  = __attribute__((ext_vector_type(4))) unsigned;
using f32x2  = __attribute__((ext_vector_type(2))) float;
using u32x2  = __attribute__((ext_vector_type(2))) unsigned;
typedef __attribute__((ext_vector_type(2))) __bf16 bf2_t;
#define DI __device__ __forceinline__

constexpr int D = 1024, NB = 16, SEQ = 4096, NCTX = 256, DP = 3840, DEPTH = 4;
constexpr int ZC = 3072, Z_SCV = 0, Z_SCG = 256, Z_Q = 512, Z_K = 1024, Z_V = 1536, Z_NG = 2048, Z_CFU = 2560, Z_CFG = 2816;
constexpr int ML = NB * SEQ;
constexpr int MC = NB * NCTX;
constexpr int MT = ML + MC;
constexpr int NTT = MT / 256;
constexpr int LDS_WORK = 131072;
constexpr int LDS_BYTES = LDS_WORK + 16;

constexpr size_t WS_WIN  = 0;
constexpr size_t WS_WOUT = WS_WIN + (size_t)DEPTH * DP * D * 2;
constexpr size_t WS_MOD  = WS_WOUT + (size_t)DEPTH * D * D * 2;
constexpr size_t MOD_BYTES = (size_t)DEPTH * 17 * 3072 * 4;
constexpr size_t WS_BAR  = WS_MOD + MOD_BYTES;
constexpr size_t WS_CTX  = WS_MOD + 1048576;
constexpr size_t WS_HM   = WS_CTX + (size_t)MC * D * 4;
constexpr size_t WS_Z    = WS_HM + (size_t)MT * D * 2;
constexpr size_t WS_Y    = WS_Z + (size_t)MT * DP * 2;
constexpr size_t WS_END  = WS_Y + (size_t)MT * D * 2;

struct Params {
  const float *x, *c, *ctx, *c_ctx, *norm_g, *w_ada, *b_ada, *w_in, *conv_sc, *rpb, *conv_cf, *conv_cf_b, *ln_cf_g, *ln_cf_b, *w_out, *final_g;
  float* out;
  unsigned char* ws;
};

DI float fexp2(float v) { return __builtin_amdgcn_exp2f(v); }
DI float sigmoid_f(float v) { return __builtin_amdgcn_rcpf(1.f + fexp2(-1.4426950408889634f * v)); }
DI float silu_f(float v) { return v * sigmoid_f(v); }
DI unsigned pk2(float a, float b) { bf2_t v; v[0] = (__bf16)a; v[1] = (__bf16)b; return __builtin_bit_cast(unsigned, v); }
DI float bflo(unsigned w) { return __uint_as_float(w << 16); }
DI float bfhi(unsigned w) { return __uint_as_float(w & 0xffff0000u); }
DI void unpack8(const uint4& v, float* f) {
  f[0] = bflo(v.x); f[1] = bfhi(v.x); f[2] = bflo(v.y); f[3] = bfhi(v.y);
  f[4] = bflo(v.z); f[5] = bfhi(v.z); f[6] = bflo(v.w); f[7] = bfhi(v.w);
}
DI int opaque_tid(int wv) {
  unsigned m = ~0u;
  asm volatile("" : "+s"(m));
  int t = wv * 64 + (int)__builtin_amdgcn_mbcnt_hi(m, __builtin_amdgcn_mbcnt_lo(m, 0u));
  asm volatile("" : "+v"(t)); return t;
}
DI void st16_wt(void* p, const uint4& v) {
  u32x4 d; d[0] = v.x; d[1] = v.y; d[2] = v.z; d[3] = v.w;
  asm volatile("global_store_dwordx4 %0, %1, off sc1" :: "v"(p), "v"(d) : "memory");
}
template <int CTRL, int RMASK> DI float dpp0(float x) { return __int_as_float(__builtin_amdgcn_update_dpp(0, __float_as_int(x), CTRL, RMASK, 0xf, false)); }
DI float wave_sum(float x) {
  x += dpp0<0xB1, 0xf>(x);
  x += dpp0<0x4E, 0xf>(x);
  x += dpp0<0x124, 0xf>(x);
  x += dpp0<0x128, 0xf>(x);
  x += dpp0<0x142, 0xa>(x);
  x += dpp0<0x143, 0xc>(x);
  return __int_as_float(__builtin_amdgcn_readlane(__float_as_int(x), 63));
}
DI void st16_nt(void* p, const uint4& v) {
  u32x4 d; d[0] = v.x; d[1] = v.y; d[2] = v.z; d[3] = v.w;
  __builtin_nontemporal_store(d, (u32x4*)p);
}
DI int clampi(int v, int lo, int hi) { return v < lo ? lo : (v > hi ? hi : v); }

#define LAS __attribute__((address_space(3)))
constexpr int BM = 256, BK = 64, HALF = 128, HTB = HALF * BK * 2;
DI int lds_byte(int r, int c) { const int st = (r >> 4) * 2 + (c >> 5), rr = r & 15, cc = c & 31, ob = rr * 64 + cc * 2; return st * 1024 + (ob ^ (((ob >> 9) & 1) << 5)); }
DI void stage_rc(int b, int& R, int& C) { const int st = b / 1024, sb = b % 1024, swz = sb ^ (((sb >> 9) & 1) << 5); R = (st >> 1) * 16 + swz / 64; C = (st & 1) * 32 + (swz % 64) / 2; }
DI int perm32(int rho) { const int n = rho >> 4, i = rho & 15; return 8 * (i >> 2) + 4 * n + (i & 3); }

DI int win_src_col(int n) {
  const int pn = n >> 8, r = n & 255, half = r >> 7, q = r & 127;
  if (pn == 0 || pn == 1) return (half ? 512 : 0) + pn * 128 + q;
  if (pn == 2 || pn == 3) return (half ? 768 : 256) + (pn - 2) * 128 + q;
  if (pn == 12 || pn == 13) return (half ? 3328 : 3072) + (pn - 12) * 128 + q;
  return n;
}

DI int logical_block() {
  int g = gridDim.x;
  if ((g & 7) == 0) return (blockIdx.x & 7) * (g >> 3) + (blockIdx.x >> 3);
  return blockIdx.x;
}

template <bool PERM, class Epi>
DI void gemm_phase(const Params& P, int wv, const u16* __restrict__ Aact, const u16* __restrict__ Wt, int ntiles, int nct, LAS unsigned char* lds, Epi&& E) {
  constexpr int K = 1024, nt = K / BK;
  const int tid = opaque_tid(wv), wid = tid >> 6, lane = tid & 63, wr = wid >> 2, wc = wid & 3, fr = lane & 15, fq = lane >> 4;
  const int G = gridDim.x;
  unsigned voffA[2], voffB[2];
  #pragma unroll
  for (int i = 0; i < 2; ++i) { int R, C; stage_rc(tid * 16 + i * 8192, R, C); const int Rb = PERM ? ((R & ~31) + perm32(R & 31)) : R;
    voffA[i] = (unsigned)(R * K + C) * 2u; voffB[i] = (unsigned)(Rb * K + C) * 2u; }
  const size_t kstep = (size_t)(BK * 2), hstep = (size_t)HALF * K * 2, tstep = 2 * hstep;
  const unsigned ldsw = (unsigned)wid * 1024u;
  const int aoff = lds_byte(wr * 64 + fr, fq * 8), boff = lds_byte(wc * 32 + fr, fq * 8);
  #define G_SA(b, h) (((b) * 2 + (h)) * HTB)
  #define G_SB(b, h) ((4 + (b) * 2 + (h)) * HTB)
  #define G_STAGE(bufoff, gbase, voff) do { _Pragma("unroll") for (int _i = 0; _i < 2; ++_i) \
      __builtin_amdgcn_global_load_lds((const unsigned*)((const char*)(gbase) + (voff)[_i]), (LAS unsigned*)(lds + (bufoff) + ldsw + _i * 8192), 16, 0, 0); } while (0)
  #define G_LDA(dst, b, h) do { _Pragma("unroll") for (int m = 0; m < 4; ++m) _Pragma("unroll") for (int k = 0; k < 2; ++k) dst[m][k] = *(const LAS bf16x8*)(lds + G_SA(b, h) + aoff + m * 2048 + k * 1024); } while (0)
  #define G_LDB(dst, b, h) do { _Pragma("unroll") for (int n = 0; n < 2; ++n) _Pragma("unroll") for (int k = 0; k < 2; ++k) dst[n][k] = *(const LAS bf16x8*)(lds + G_SB(b, h) + boff + n * 2048 + k * 1024); } while (0)
  #define G_MMA(ai, bj, At, Bt) do { __builtin_amdgcn_s_setprio(1); _Pragma("unroll") for (int m = 0; m < 4; ++m) _Pragma("unroll") for (int n = 0; n < 2; ++n) _Pragma("unroll") for (int k = 0; k < 2; ++k) \
      acc[ai][bj][m][n] = __builtin_amdgcn_mfma_f32_16x16x32_bf16(Bt[n][k], At[m][k], acc[ai][bj][m][n], 0, 0, 0); __builtin_amdgcn_s_setprio(0); } while (0)
  #define G_WAIT_V(n) asm volatile("s_waitcnt vmcnt(" #n ")" ::: "memory")
  #define G_WAIT_L(n) asm volatile("s_waitcnt lgkmcnt(" #n ")" ::: "memory")
  #define G_BAR __builtin_amdgcn_s_barrier()
  #define G_SCHED __builtin_amdgcn_sched_barrier(0)
  const int ntm = ntiles / nct;
  auto unit = [&](int i, int& pm, int& pn) __attribute__((always_inline)) -> bool {
    const int Lg = i * G + blockIdx.x;
    if (Lg >= ntiles) return false;
    int wg = Lg;
    { const int q = ntiles >> 3, r = ntiles & 7, xcd = wg & 7, off = wg >> 3; wg = (xcd < r ? xcd * (q + 1) : r * (q + 1) + (xcd - r) * q) + off; }
    const int nig = 8 * nct, gid = wg / nig, fm = gid * 8, gsz = (ntm - fm) < 8 ? (ntm - fm) : 8;
    const int rem = wg - gid * nig;
    pm = fm + rem % gsz; pn = rem / gsz; return true;
  };
  int ui = 0, cpm, cpn, npm = 0, npn = 0;
  if (!unit(0, cpm, cpn)) return;
  f32x4 acc[2][2][4][2];
  #pragma unroll
  for (int a = 0; a < 2; ++a)
  #pragma unroll
    for (int b = 0; b < 2; ++b)
  #pragma unroll
      for (int m = 0; m < 4; ++m)
  #pragma unroll
        for (int n = 0; n < 2; ++n) acc[a][b][m][n] = (f32x4){0.f, 0.f, 0.f, 0.f};
  bf16x8 At[4][2], B0[2][2], B1[2][2];
  const char* cA = (const char*)Aact + (size_t)cpm * tstep; const char* cB = (const char*)Wt + (size_t)cpn * tstep;
  G_WAIT_V(0);
  G_STAGE(G_SB(0, 0), cB, voffB); G_STAGE(G_SA(0, 0), cA, voffA); G_STAGE(G_SB(0, 1), cB + hstep, voffB); G_STAGE(G_SA(0, 1), cA + hstep, voffA);
  if (wr == 1) G_BAR;
  G_WAIT_V(4); G_BAR;
  G_STAGE(G_SB(1, 0), cB + kstep, voffB); G_STAGE(G_SA(1, 0), cA + kstep, voffA); G_STAGE(G_SB(1, 1), cB + hstep + kstep, voffB);
  G_WAIT_V(6); G_BAR;
  for (;;) {
    bool has_next;
    has_next = unit(ui + 1, npm, npn);
    const char* nA = has_next ? (const char*)Aact + (size_t)npm * tstep : cA; const char* nB = has_next ? (const char*)Wt + (size_t)npn * tstep : cB;
    for (int t = 0; t < nt; t += 2) {
      const bool last = (t == nt - 2);
      const char* a1 = cA + (size_t)(t + 1) * kstep;
      const char* a2 = last ? nA : cA + (size_t)(t + 2) * kstep; const char* b2 = last ? nB : cB + (size_t)(t + 2) * kstep;
      const char* a3 = a2 + kstep; const char* b3 = b2 + kstep;
      G_LDB(B0, 0, 0); G_SCHED; G_LDA(At, 0, 0); G_STAGE(G_SA(1, 1), a1 + hstep, voffA);
      G_WAIT_L(8); G_BAR; G_WAIT_L(0); G_MMA(0, 0, At, B0); G_BAR; G_SCHED;
      G_LDB(B1, 0, 1); G_STAGE(G_SB(0, 0), b2, voffB);
      G_BAR; G_WAIT_L(0); G_MMA(0, 1, At, B1); G_BAR;
      G_LDA(At, 0, 1); G_STAGE(G_SA(0, 0), a2, voffA);
      G_BAR; G_WAIT_L(0); G_MMA(1, 0, At, B0); G_BAR; G_SCHED;
      G_STAGE(G_SB(0, 1), b2 + hstep, voffB);
      G_WAIT_V(6); G_BAR; G_MMA(1, 1, At, B1); G_BAR;
      G_LDB(B0, 1, 0); G_SCHED; G_LDA(At, 1, 0); G_STAGE(G_SA(0, 1), a2 + hstep, voffA);
      G_WAIT_L(8); G_BAR; G_WAIT_L(0); G_MMA(0, 0, At, B0); G_BAR; G_SCHED;
      G_LDB(B1, 1, 1); G_STAGE(G_SB(1, 0), b3, voffB);
      G_BAR; G_WAIT_L(0); G_MMA(0, 1, At, B1); G_BAR;
      G_LDA(At, 1, 1); G_STAGE(G_SA(1, 0), a3, voffA);
      G_BAR; G_WAIT_L(0); G_MMA(1, 0, At, B0); G_BAR; G_SCHED;
      G_STAGE(G_SB(1, 1), b3 + hstep, voffB);
      G_WAIT_V(6); G_BAR; G_MMA(1, 1, At, B1); G_BAR;
    }
    E(acc, cpm, cpn, wr, wc, fr, fq);
    if (!has_next) break;
    #pragma unroll
    for (int a = 0; a < 2; ++a)
    #pragma unroll
      for (int b = 0; b < 2; ++b)
    #pragma unroll
        for (int m = 0; m < 4; ++m)
    #pragma unroll
          for (int n = 0; n < 2; ++n) acc[a][b][m][n] = (f32x4){0.f, 0.f, 0.f, 0.f};
    cpm = npm; cpn = npn; cA = nA; cB = nB; ++ui;
  }
  G_WAIT_V(0);
  if (wr == 0) G_BAR;
  G_BAR;
  #undef G_SA
  #undef G_SB
  #undef G_STAGE
  #undef G_LDA
  #undef G_LDB
  #undef G_MMA
  #undef G_WAIT_V
  #undef G_WAIT_L
  #undef G_BAR
  #undef G_SCHED
}

DI void transpose_tiles(const Params& P, int tid, char* lds, int l, int first, int stride) {
  u16* winT = (u16*)(P.ws + WS_WIN) + (size_t)l * DP * D;
  u16* woutT = (u16*)(P.ws + WS_WOUT) + (size_t)l * D * D;
  float* tile = (float*)lds;
  for (int t2 = first; t2 < 960 + 256; t2 += stride) {
    const float* src; u16* dst; int N, kt, ntile, n_src;
    if (t2 < 960) { kt = t2 / 60; ntile = t2 % 60; N = DP; src = P.w_in + (size_t)l * D * DP; dst = winT; n_src = win_src_col(ntile * 64); }
    else { const int r2 = t2 - 960; kt = r2 >> 4; ntile = r2 & 15; N = D; src = P.w_out + (size_t)l * D * D; dst = woutT; n_src = ntile * 64; }
    const int k0 = kt * 64, n0 = ntile * 64;
    {
      const int r = tid >> 4, c4 = tid & 15;
      #pragma unroll
      for (int hh = 0; hh < 2; ++hh) {
        float4 v = *(const float4*)(src + (size_t)(k0 + r + hh * 32) * N + n_src + c4 * 4);
        float* tp = tile + (r + hh * 32) * 65 + c4 * 4;
        tp[0] = v.x; tp[1] = v.y; tp[2] = v.z; tp[3] = v.w;
      }
    }
    __syncthreads();
    {
      const int n = tid >> 3, kc = tid & 7;
      float f[8];
      #pragma unroll
      for (int e = 0; e < 8; ++e) f[e] = tile[(kc * 8 + e) * 65 + n];
      uint4 o; o.x = pk2(f[0], f[1]); o.y = pk2(f[2], f[3]); o.z = pk2(f[4], f[5]); o.w = pk2(f[6], f[7]);
      *(uint4*)(dst + (size_t)(n0 + n) * D + k0 + kc * 8) = o;
    }
    __syncthreads();
  }
}

DI void phase0(const Params& P, int wv, char* lds) {
  const int tid = opaque_tid(wv);
  float* mod = (float*)(P.ws + WS_MOD);
  constexpr int NG = 192;
  for (int task = blockIdx.x; task < NG; task += gridDim.x) {
    const int l = task / 48, rem = task % 48, nc = rem >> 3, ks = rem & 7;
    float* s = (float*)lds;
    for (int id = tid; id < 17 * 128; id += 512) {
      int r = id >> 7, kk = id & 127;
      float v = (r < 16) ? P.c[r * D + ks * 128 + kk] : P.c_ctx[ks * 128 + kk];
      s[id] = silu_f(v);
    }
    __syncthreads();
    const int n = nc * 512 + tid;
    float acc[17];
    #pragma unroll
    for (int r = 0; r < 17; ++r) acc[r] = 0.f;
    const float* wp = P.w_ada + ((size_t)l * D + ks * 128) * 3072 + n;
    for (int k4 = 0; k4 < 32; ++k4) {
      float w0 = wp[(size_t)(k4 * 4 + 0) * 3072], w1 = wp[(size_t)(k4 * 4 + 1) * 3072];
      float w2 = wp[(size_t)(k4 * 4 + 2) * 3072], w3 = wp[(size_t)(k4 * 4 + 3) * 3072];
      #pragma unroll
      for (int r = 0; r < 17; ++r) {
        float4 sv = *(const float4*)(s + r * 128 + k4 * 4);
        acc[r] += sv.x * w0 + sv.y * w1 + sv.z * w2 + sv.w * w3;
      }
    }
    const float bias = (ks == 0) ? P.b_ada[l * 3072 + n] : 0.f;
    #pragma unroll
    for (int r = 0; r < 17; ++r) atomicAdd(mod + ((size_t)l * 17 + r) * 3072 + n, acc[r] + bias);
    __syncthreads();
  }
  transpose_tiles(P, tid, lds, 0, (blockIdx.x + gridDim.x - NG % gridDim.x) % gridDim.x, gridDim.x);
}

DI void phase_resnorm(const Params& P, int wv, int l) {
  const int tid = opaque_tid(wv), lane = tid & 63;
  const float* modl = (const float*)(P.ws + WS_MOD) + (size_t)(l < DEPTH ? l : 0) * 17 * 3072;
  const float* modp = (const float*)(P.ws + WS_MOD) + (size_t)(l > 0 ? l - 1 : 0) * 17 * 3072;
  float* ctxs = (float*)(P.ws + WS_CTX);
  u16* h = (u16*)(P.ws + WS_HM);
  const u16* y = (const u16*)(P.ws + WS_Y);
  const bool fin = (l == DEPTH);
  const float* g = fin ? P.final_g : P.norm_g + l * D;
  const int nrows = fin ? ML : MT;
  const int nw = gridDim.x * 8;
  float4 gg[4];
  #pragma unroll
  for (int i = 0; i < 4; ++i) gg[i] = *(const float4*)(g + (i * 64 + lane) * 4);
  for (int row0 = blockIdx.x * 8 + wv; row0 < nrows; row0 += 2 * nw) {
    float4 v[2][4], gt[2][4], sh[2][4], sc[2][4];
    uint2 yv[2][4];
    float* dst[2]; bool ok[2];
    #pragma unroll
    for (int k = 0; k < 2; ++k) {
      const int row = row0 + k * nw;
      ok[k] = row < nrows;
      const int rw = ok[k] ? row : row0;
      const float* src; int rr;
      if (rw < ML) { src = (l <= 1 ? P.x : P.out) + (size_t)rw * D; dst[k] = P.out + (size_t)rw * D; rr = rw >> 12; }
      else { src = (l <= 1 ? P.ctx : ctxs) + (size_t)(rw - ML) * D; dst[k] = ctxs + (size_t)(rw - ML) * D; rr = 16; }
      #pragma unroll
      for (int i = 0; i < 4; ++i) { const f32x4 t = __builtin_nontemporal_load((const f32x4*)(src + (i * 64 + lane) * 4)); v[k][i] = make_float4(t[0], t[1], t[2], t[3]); }
      if (l > 0) {
        #pragma unroll
        for (int i = 0; i < 4; ++i) {
          { const u32x2 t = __builtin_nontemporal_load((const u32x2*)(y + (size_t)rw * D + (i * 64 + lane) * 4)); yv[k][i] = make_uint2(t[0], t[1]); }
          gt[k][i] = *(const float4*)(modp + rr * 3072 + 2048 + (i * 64 + lane) * 4);
        }
      }
      if (!fin) {
        #pragma unroll
        for (int i = 0; i < 4; ++i) {
          sh[k][i] = *(const float4*)(modl + rr * 3072 + (i * 64 + lane) * 4);
          sc[k][i] = *(const float4*)(modl + rr * 3072 + 1024 + (i * 64 + lane) * 4);
        }
      }
    }
    __builtin_amdgcn_sched_barrier(0);
    #pragma unroll
    for (int k = 0; k < 2; ++k) {
      if (!ok[k]) continue;
      const int row = row0 + k * nw;
      float ss = 0.f;
      if (l > 0) {
        #pragma unroll
        for (int i = 0; i < 4; ++i) {
          v[k][i].x += gt[k][i].x * bflo(yv[k][i].x); v[k][i].y += gt[k][i].y * bfhi(yv[k][i].x);
          v[k][i].z += gt[k][i].z * bflo(yv[k][i].y); v[k][i].w += gt[k][i].w * bfhi(yv[k][i].y);
          if (!fin) { f32x4 t; t[0] = v[k][i].x; t[1] = v[k][i].y; t[2] = v[k][i].z; t[3] = v[k][i].w; __builtin_nontemporal_store(t, (f32x4*)(dst[k] + (i * 64 + lane) * 4)); }
        }
      }
      #pragma unroll
      for (int i = 0; i < 4; ++i) ss += v[k][i].x * v[k][i].x + v[k][i].y * v[k][i].y + v[k][i].z * v[k][i].z + v[k][i].w * v[k][i].w;
      ss = wave_sum(ss);
      const float rstd = rsqrtf(ss * (1.f / D) + 1e-6f);
      if (fin) {
        #pragma unroll
        for (int i = 0; i < 4; ++i) {
          const int c = (i * 64 + lane) * 4;
          f32x4 o; o[0] = v[k][i].x * rstd * gg[i].x; o[1] = v[k][i].y * rstd * gg[i].y; o[2] = v[k][i].z * rstd * gg[i].z; o[3] = v[k][i].w * rstd * gg[i].w;
          __builtin_nontemporal_store(o, (f32x4*)(dst[k] + c));
        }
      } else {
        #pragma unroll
        for (int i = 0; i < 4; ++i) {
          const int c = (i * 64 + lane) * 4;
          const float a0 = v[k][i].x * rstd * gg[i].x * (1.f + sc[k][i].x) + sh[k][i].x;
          const float a1 = v[k][i].y * rstd * gg[i].y * (1.f + sc[k][i].y) + sh[k][i].y;
          const float a2 = v[k][i].z * rstd * gg[i].z * (1.f + sc[k][i].z) + sh[k][i].z;
          const float a3 = v[k][i].w * rstd * gg[i].w * (1.f + sc[k][i].w) + sh[k][i].w;
          uint2 o; o.x = pk2(a0, a1); o.y = pk2(a2, a3);
          *(uint2*)(h + (size_t)row * D + c) = o;
        }
      }
    }
  }
}

DI void phase_inproj(const Params& P, int wv, int l, char* lds) {
  const u16* W = (const u16*)(P.ws + WS_WIN) + (size_t)l * DP * D;
  const u16* h = (const u16*)(P.ws + WS_HM);
  u16* z = (u16*)(P.ws + WS_Z);
  constexpr int NCT = DP / 256;
  gemm_phase<true>(P, wv, h, W, NTT * NCT, NCT, (LAS unsigned char*)lds,
    [&](const f32x4 (&acc)[2][2][4][2], int pm, int pn, int wr, int wc, int fr, int fq) __attribute__((always_inline)) {
      const int row0 = pm * BM + wr * 64 + fr, cw = wc * 32 + 8 * fq;
      if (pn >= 4 && pn < 10) {
        u16* zp = z + Z_Q + (pn - 4) * 256 + cw;
        #pragma unroll
        for (int ai = 0; ai < 2; ++ai)
        #pragma unroll
          for (int m = 0; m < 4; ++m) {
            u16* rowp = zp + (size_t)(row0 + ai * HALF + m * 16) * ZC;
            #pragma unroll
            for (int bj = 0; bj < 2; ++bj) {
              const f32x4 v0 = acc[ai][bj][m][0], v1 = acc[ai][bj][m][1];
              uint4 o; o.x = pk2(v0[0], v0[1]); o.y = pk2(v0[2], v0[3]); o.z = pk2(v1[0], v1[1]); o.w = pk2(v1[2], v1[3]);
              st16_nt(rowp + bj * HALF, o);
            }
          }
      } else if (pn == 10 || pn == 11 || pn == 14) {
        u16* zp = z + (pn == 14 ? Z_CFG : Z_NG + (pn - 10) * 256) + cw;
        #pragma unroll
        for (int ai = 0; ai < 2; ++ai)
        #pragma unroll
          for (int m = 0; m < 4; ++m) {
            u16* rowp = zp + (size_t)(row0 + ai * HALF + m * 16) * ZC;
            #pragma unroll
            for (int bj = 0; bj < 2; ++bj) {
              const f32x4 v0 = acc[ai][bj][m][0], v1 = acc[ai][bj][m][1];
              uint4 o; o.x = pk2(silu_f(v0[0]), silu_f(v0[1])); o.y = pk2(silu_f(v0[2]), silu_f(v0[3]));
              o.z = pk2(silu_f(v1[0]), silu_f(v1[1])); o.w = pk2(silu_f(v1[2]), silu_f(v1[3]));
              st16_nt(rowp + bj * HALF, o);
            }
          }
      } else {
        const int mode = (pn < 2) ? 0 : (pn < 4 ? 1 : 2);
        const int ob = (pn < 2) ? Z_SCV + pn * 128 : (pn < 4 ? Z_SCG + (pn - 2) * 128 : Z_CFU + (pn - 12) * 128);
        u16* zp = z + ob + cw;
        #pragma unroll
        for (int ai = 0; ai < 2; ++ai)
        #pragma unroll
          for (int m = 0; m < 4; ++m) {
            float o8[8];
            #pragma unroll
            for (int n = 0; n < 2; ++n)
            #pragma unroll
              for (int j = 0; j < 4; ++j) {
                const float a = acc[ai][0][m][n][j], b = acc[ai][1][m][n][j];
                o8[n * 4 + j] = a * (mode == 0 ? b : (mode == 1 ? silu_f(b) : sigmoid_f(b)));
              }
            uint4 o; o.x = pk2(o8[0], o8[1]); o.y = pk2(o8[2], o8[3]); o.z = pk2(o8[4], o8[5]); o.w = pk2(o8[6], o8[7]);
            st16_nt(zp + (size_t)(row0 + ai * HALF + m * 16) * ZC, o);
          }
      }
    });
}

DI void phase_outproj(const Params& P, int wv, int l, char* lds) {
  const u16* W = (const u16*)(P.ws + WS_WOUT) + (size_t)l * D * D;
  const u16* mm = (const u16*)(P.ws + WS_HM);
  u16* y = (u16*)(P.ws + WS_Y);
  const int ntt = (l == DEPTH - 1) ? (ML / 256) : NTT;
  gemm_phase<true>(P, wv, mm, W, ntt * 4, 4, (LAS unsigned char*)lds,
    [&](const f32x4 (&acc)[2][2][4][2], int pm, int pn, int wr, int wc, int fr, int fq) __attribute__((always_inline)) {
      const int row0 = pm * BM + wr * 64 + fr, col0 = pn * BM + wc * 32 + 8 * fq;
      #pragma unroll
      for (int ai = 0; ai < 2; ++ai)
      #pragma unroll
        for (int m = 0; m < 4; ++m) {
          u16* rowp = y + (size_t)(row0 + ai * HALF + m * 16) * D + col0;
          #pragma unroll
          for (int bj = 0; bj < 2; ++bj) {
            const f32x4 v0 = acc[ai][bj][m][0], v1 = acc[ai][bj][m][1];
            uint4 o; o.x = pk2(v0[0], v0[1]); o.y = pk2(v0[2], v0[3]); o.z = pk2(v1[0], v1[1]); o.w = pk2(v1[2], v1[3]);
            *(uint4*)(rowp + bj * HALF) = o;
          }
        }
    });
  if (l + 1 < DEPTH) {
    const int busy = ntt * 4 - 4 * (int)gridDim.x;
    if (busy > 0 && busy < (int)gridDim.x && (int)blockIdx.x >= busy)
      transpose_tiles(P, opaque_tid(wv), lds, l + 1, (int)blockIdx.x - busy, (int)gridDim.x - busy);
    else if (busy <= 0 || busy >= (int)gridDim.x)
      transpose_tiles(P, opaque_tid(wv), lds, l + 1, (int)blockIdx.x, (int)gridDim.x);
  }
}

constexpr int BIAS_OFF = 832 * 128;
struct AttnTask { int b, h, r0, half, lat; };
DI AttnTask attn_decode(int task) {
  AttnTask t; t.lat = (task < 4096) ? 1 : 0; t.r0 = 0; t.half = 0;
  if (t.lat) { t.b = task >> 8; t.h = (task >> 5) & 7; t.r0 = (task & 31) * 2; }
  else { const int t2 = task - 4096; t.b = t2 >> 4; t.h = (t2 >> 1) & 7; t.half = t2 & 1; }
  return t;
}

DI void attn_loop(const Params& P, int wv, int l, int n_attn, char* lds_g, int r_begin, int r_end) {
  LAS char* lds = (LAS char*)lds_g;
  const u16* z = (const u16*)(P.ws + WS_Z);
  u16* mb = (u16*)(P.ws + WS_HM);
  const int tid = opaque_tid(wv);
  const int G = gridDim.x;
  int task = logical_block() + r_begin * G, round = r_begin;
  if (task >= n_attn || r_begin >= r_end) return;

  int lane, fr, fq, w, st_lds, kl0, kl1, tl[4];
  const u16* zl;
  auto lane_consts = [&](int tq) __attribute__((always_inline)) {
    lane = tq & 63; fr = lane & 15; fq = lane >> 4;
    w = __builtin_amdgcn_readfirstlane(tq >> 6);
    const int st_row = tq >> 3, st_c = tq & 7;
    st_lds = st_row * 128 + ((st_c ^ (((st_row >> 1) & 3) << 1) ^ ((st_row >> 3) & 1)) << 4);
    zl = z + (size_t)st_row * ZC + st_c * 8;
    const int ksw = (((fr >> 1) & 3) << 1) ^ (fr >> 3);
    kl0 = fr * 128 + ((fq ^ ksw) << 4);
    kl1 = fr * 128 + (((fq + 4) ^ ksw) << 4);
    const int q4 = fr >> 2, p4 = fr & 3, trow = 4 * fq + q4, tsw = (((trow >> 1) & 3) << 1) ^ (fq >> 1);
    #pragma unroll
    for (int mbk = 0; mbk < 4; ++mbk) tl[mbk] = trow * 128 + (((2 * mbk + (p4 >> 1)) ^ tsw) << 4) + 8 * (p4 & 1);
  };
  lane_consts(tid);
  typedef LAS s16x4* lds_s16x4_p;
  constexpr float LOG2E = 1.4426950408889634f;
  constexpr float SC2 = 0.125f * LOG2E;

  u32x4 rg[13];
  float brg[2];
  auto load_img = [&](const AttnTask& t, int coloff) __attribute__((always_inline)) {
    const size_t ctxbase = (size_t)ML + t.b * NCTX;
    const int rs0 = clampi(t.r0 - 4, 0, 56);
    #pragma unroll
    for (int i = 0; i < 4; ++i) rg[9 + i] = *(const u32x4*)(zl + (ctxbase + i * 64) * ZC + coloff);
    if (t.lat) {
      #pragma unroll
      for (int i = 0; i < 9; ++i) {
        const int gr = min(rs0 + i, 63);
        rg[i] = *(const u32x4*)(zl + ((size_t)t.b * SEQ + gr * 64) * ZC + coloff);
      }
    }
  };
  auto store_img = [&](const AttnTask& t) __attribute__((always_inline)) {
    if (t.lat) {
      #pragma unroll
      for (int i = 0; i < 9; ++i) *(LAS u32x4*)(lds + st_lds + i * 8192) = rg[i];
    }
    #pragma unroll
    for (int i = 0; i < 4; ++i) *(LAS u32x4*)(lds + st_lds + (9 + i) * 8192) = rg[9 + i];
  };
  auto load_bias = [&](const AttnTask& t) __attribute__((always_inline)) {
    if (t.lat) {
      #pragma unroll
      for (int j = 0; j < 2; ++j) {
        const int id = tid + j * 512, ri = id >> 6, ci = (id & 63) - 16;
        brg[j] = (id < 960 && ci >= 0 && ci < 31) ? P.rpb[((size_t)l * 8 + t.h) * 465 + ri * 31 + ci] * LOG2E : 0.f;
      }
    }
  };

  AttnTask cur = attn_decode(task);
  load_img(cur, Z_K + cur.h * 64);
  load_bias(cur);
  for (;;) {
    { int tq = tid; asm volatile("" : "+v"(tq)); lane_consts(tq); }
    store_img(cur);
    if (cur.lat) {
      ((LAS float*)(lds + BIAS_OFF))[tid] = brg[0];
      if (tid < 960 - 512) ((LAS float*)(lds + BIAS_OFF))[tid + 512] = brg[1];
    }
    load_img(cur, Z_V + cur.h * 64);
    const int b = cur.b, h = cur.h;
    const size_t ctxbase = (size_t)ML + b * NCTX;
    const int rs0 = clampi(cur.r0 - 4, 0, 56);
    int r = 0, c0 = 0, rs = 0, rowoff = 0, cb = 0;
    size_t qtok;
    if (cur.lat) {
      r = cur.r0 + (w >> 2); c0 = 16 * (w & 3); rs = clampi(r - 4, 0, 56); rowoff = rs - rs0; cb = clampi(c0 - 8, 0, 32);
      qtok = (size_t)b * SEQ + r * 64 + c0 + fr;
    } else {
      qtok = ctxbase + cur.half * 128 + w * 16 + fr;
    }
    const int wb = (rowoff * 64 + cb) * 128;
    const int pbx = ((cb >> 3) & 1) << 4;
    const bf16x8 qf0 = *(const bf16x8*)(z + qtok * ZC + Z_Q + h * 64 + fq * 8);
    const bf16x8 qf1 = *(const bf16x8*)(z + qtok * ZC + Z_Q + h * 64 + 32 + fq * 8);
    __syncthreads();

    bf16x8 pc[8], pw[8];
    float mc, lc = 0.f, mw = -1e30f, lw = 0.f;
    {
      f32x4 sc[16];
      float mxc = -1e30f;
      bf16x8 fa[4], fb[4];
      #pragma unroll
      for (int u = 0; u < 2; ++u) {
        fa[2 * u]     = *(const LAS bf16x8*)(lds + 73728 + kl0 + u * 2048);
        fa[2 * u + 1] = *(const LAS bf16x8*)(lds + 73728 + kl1 + u * 2048);
      }
      #pragma unroll
      for (int g = 0; g < 8; ++g) {
        if (g + 1 < 8) {
          #pragma unroll
          for (int u = 0; u < 2; ++u) {
            const bf16x8 x0 = *(const LAS bf16x8*)(lds + 73728 + kl0 + (2 * g + 2 + u) * 2048);
            const bf16x8 x1 = *(const LAS bf16x8*)(lds + 73728 + kl1 + (2 * g + 2 + u) * 2048);
            if (g & 1) { fa[2 * u] = x0; fa[2 * u + 1] = x1; } else { fb[2 * u] = x0; fb[2 * u + 1] = x1; }
          }
        }
        __builtin_amdgcn_sched_barrier(0);
        #pragma unroll
        for (int u = 0; u < 2; ++u) {
          const bf16x8 k0 = (g & 1) ? fb[2 * u] : fa[2 * u];
          const bf16x8 k1 = (g & 1) ? fb[2 * u + 1] : fa[2 * u + 1];
          f32x4 a = {0.f, 0.f, 0.f, 0.f};
          a = __builtin_amdgcn_mfma_f32_16x16x32_bf16(k0, qf0, a, 0, 0, 0);
          a = __builtin_amdgcn_mfma_f32_16x16x32_bf16(k1, qf1, a, 0, 0, 0);
          #pragma unroll
          for (int i = 0; i < 4; ++i) mxc = fmaxf(mxc, a[i]);
          sc[2 * g + u] = a;
        }
        __builtin_amdgcn_sched_barrier(0);
      }
      mxc = fmaxf(mxc, __shfl_xor(mxc, 16));
      mxc = fmaxf(mxc, __shfl_xor(mxc, 32));
      mc = mxc * SC2;
      #pragma unroll
      for (int jj = 0; jj < 8; ++jj) {
        float e[8];
        #pragma unroll
        for (int i = 0; i < 4; ++i) { e[i] = fexp2(sc[2 * jj][i] * SC2 - mc); e[4 + i] = fexp2(sc[2 * jj + 1][i] * SC2 - mc); }
        #pragma unroll
        for (int i = 0; i < 8; ++i) lc += e[i];
        u32x4 bu; bu[0] = pk2(e[0], e[1]); bu[1] = pk2(e[2], e[3]); bu[2] = pk2(e[4], e[5]); bu[3] = pk2(e[6], e[7]);
        pc[jj] = __builtin_bit_cast(bf16x8, bu);
      }
    }
    if (cur.lat) {
      const int qc = c0 + fr, cs = clampi(qc - 8, 0, 48);
      bool vm[4];
      int boff[4];
      const int bci = cb - c0 + 15 + 4 * fq - fr + 16;
      #pragma unroll
      for (int i = 0; i < 4; ++i) { const int kc = cb + 4 * fq + i; vm[i] = (kc >= cs) && (kc < cs + 16); boff[i] = bci + i + (vm[i] ? 0 : 16); }
      const LAS float* bl = (const LAS float*)(lds + BIAS_OFF) + (rs - r + 7) * 64;
      const int wk0 = wb + (kl0 ^ pbx), wk1 = wb + (kl1 ^ pbx);
      f32x4 sw[8];
      float mxw = -1e30f;
      bf16x8 fa[4], fb[4];
      float ba[4], bb[4];
      fa[0] = *(const LAS bf16x8*)(lds + wk0); fa[1] = *(const LAS bf16x8*)(lds + wk1);
      fa[2] = *(const LAS bf16x8*)(lds + wk0 + 2048); fa[3] = *(const LAS bf16x8*)(lds + wk1 + 2048);
      #pragma unroll
      for (int i = 0; i < 4; ++i) ba[i] = bl[boff[i]];
      #pragma unroll
      for (int jj = 0; jj < 8; ++jj) {
        if (jj + 1 < 8) {
          const bf16x8 x0 = *(const LAS bf16x8*)(lds + wk0 + (jj + 1) * 8192), x1 = *(const LAS bf16x8*)(lds + wk1 + (jj + 1) * 8192);
          const bf16x8 x2 = *(const LAS bf16x8*)(lds + wk0 + (jj + 1) * 8192 + 2048), x3 = *(const LAS bf16x8*)(lds + wk1 + (jj + 1) * 8192 + 2048);
          if (jj & 1) { fa[0] = x0; fa[1] = x1; fa[2] = x2; fa[3] = x3; } else { fb[0] = x0; fb[1] = x1; fb[2] = x2; fb[3] = x3; }
          #pragma unroll
          for (int i = 0; i < 4; ++i) { const float t = bl[(jj + 1) * 64 + boff[i]]; if (jj & 1) ba[i] = t; else bb[i] = t; }
        }
        __builtin_amdgcn_sched_barrier(0);
        f32x4 a0 = {0.f, 0.f, 0.f, 0.f}, a1 = {0.f, 0.f, 0.f, 0.f};
        a0 = __builtin_amdgcn_mfma_f32_16x16x32_bf16((jj & 1) ? fb[0] : fa[0], qf0, a0, 0, 0, 0);
        a0 = __builtin_amdgcn_mfma_f32_16x16x32_bf16((jj & 1) ? fb[1] : fa[1], qf1, a0, 0, 0, 0);
        a1 = __builtin_amdgcn_mfma_f32_16x16x32_bf16((jj & 1) ? fb[2] : fa[2], qf0, a1, 0, 0, 0);
        a1 = __builtin_amdgcn_mfma_f32_16x16x32_bf16((jj & 1) ? fb[3] : fa[3], qf1, a1, 0, 0, 0);
        f32x4 a;
        #pragma unroll
        for (int i = 0; i < 4; ++i) {
          const float bias = (jj & 1) ? bb[i] : ba[i];
          a[i] = (vm[i] ? a0[i] : a1[i]) * SC2 + bias;
          mxw = fmaxf(mxw, a[i]);
        }
        sw[jj] = a;
        __builtin_amdgcn_sched_barrier(0);
      }
      mxw = fmaxf(mxw, __shfl_xor(mxw, 16));
      mxw = fmaxf(mxw, __shfl_xor(mxw, 32));
      mw = mxw;
      #pragma unroll
      for (int jj = 0; jj < 8; ++jj) {
        float e0[4], e1[4];
        #pragma unroll
        for (int i = 0; i < 4; ++i) {
          const float e = fexp2(sw[jj][i] - mw);
          lw += e;
          e0[i] = vm[i] ? e : 0.f; e1[i] = vm[i] ? 0.f : e;
        }
        u32x4 bu; bu[0] = pk2(e0[0], e0[1]); bu[1] = pk2(e0[2], e0[3]); bu[2] = pk2(e1[0], e1[1]); bu[3] = pk2(e1[2], e1[3]);
        pw[jj] = __builtin_bit_cast(bf16x8, bu);
      }
    } else {
      #pragma unroll
      for (int jj = 0; jj < 8; ++jj) pw[jj] = (bf16x8){0, 0, 0, 0, 0, 0, 0, 0};
    }
    lc += __shfl_xor(lc, 16); lc += __shfl_xor(lc, 32);
    lw += __shfl_xor(lw, 16); lw += __shfl_xor(lw, 32);
    const float mfin = fmaxf(mc, mw);
    const float fc = fexp2(mc - mfin), fw = fexp2(mw - mfin);
    const float inv = __builtin_amdgcn_rcpf(lc * fc + lw * fw);
    const float gc = fc * inv, gw = fw * inv;

    __syncthreads();
    store_img(cur);
    const int ntask = task + G;
    const bool has_next = (ntask < n_attn) && (round + 1 < r_end);
    AttnTask nxt = cur;
    if (has_next) { nxt = attn_decode(ntask); load_img(nxt, Z_K + nxt.h * 64); load_bias(nxt); }
    __syncthreads();

    uint2 gv[4];
    #pragma unroll
    for (int mbk = 0; mbk < 4; ++mbk) gv[mbk] = *(const uint2*)(z + qtok * ZC + Z_NG + h * 64 + 16 * mbk + 4 * fq);
    f32x4 oc[4], ow[4];
    #pragma unroll
    for (int mbk = 0; mbk < 4; ++mbk) { f32x4 zz = {0.f, 0.f, 0.f, 0.f}; oc[mbk] = zz; ow[mbk] = zz; }
    {
      s16x4 r3[3][8];
      #pragma unroll
      for (int p = 0; p < 2; ++p)
      #pragma unroll
        for (int mbk = 0; mbk < 4; ++mbk) {
          r3[p][2 * mbk]     = __builtin_amdgcn_ds_read_tr16_b64_v4i16((lds_s16x4_p)(lds + 73728 + tl[mbk] + p * 4096));
          r3[p][2 * mbk + 1] = __builtin_amdgcn_ds_read_tr16_b64_v4i16((lds_s16x4_p)(lds + 73728 + tl[mbk] + p * 4096 + 2048));
        }
      #pragma unroll
      for (int jj = 0; jj < 8; ++jj) {
        if (jj + 2 < 8) {
          #pragma unroll
          for (int mbk = 0; mbk < 4; ++mbk) {
            r3[(jj + 2) % 3][2 * mbk]     = __builtin_amdgcn_ds_read_tr16_b64_v4i16((lds_s16x4_p)(lds + 73728 + tl[mbk] + (jj + 2) * 4096));
            r3[(jj + 2) % 3][2 * mbk + 1] = __builtin_amdgcn_ds_read_tr16_b64_v4i16((lds_s16x4_p)(lds + 73728 + tl[mbk] + (jj + 2) * 4096 + 2048));
          }
        }
        __builtin_amdgcn_sched_barrier(0);
        #pragma unroll
        for (int mbk = 0; mbk < 4; ++mbk) {
          const bf16x8 av = __builtin_shufflevector(r3[jj % 3][2 * mbk], r3[jj % 3][2 * mbk + 1], 0, 1, 2, 3, 4, 5, 6, 7);
          oc[mbk] = __builtin_amdgcn_mfma_f32_16x16x32_bf16(av, pc[jj], oc[mbk], 0, 0, 0);
        }
        __builtin_amdgcn_sched_barrier(0);
      }
    }
    if (cur.lat) {
      s16x4 r3[3][8];
      const int tw = wb;
      #pragma unroll
      for (int p = 0; p < 2; ++p)
      #pragma unroll
        for (int mbk = 0; mbk < 4; ++mbk) {
          const int ta = tw + (tl[mbk] ^ pbx) + p * 8192;
          r3[p][2 * mbk]     = __builtin_amdgcn_ds_read_tr16_b64_v4i16((lds_s16x4_p)(lds + ta));
          r3[p][2 * mbk + 1] = __builtin_amdgcn_ds_read_tr16_b64_v4i16((lds_s16x4_p)(lds + ta + 2048));
        }
      #pragma unroll
      for (int jj = 0; jj < 8; ++jj) {
        if (jj + 2 < 8) {
          #pragma unroll
          for (int mbk = 0; mbk < 4; ++mbk) {
            const int ta = tw + (tl[mbk] ^ pbx) + (jj + 2) * 8192;
            r3[(jj + 2) % 3][2 * mbk]     = __builtin_amdgcn_ds_read_tr16_b64_v4i16((lds_s16x4_p)(lds + ta));
            r3[(jj + 2) % 3][2 * mbk + 1] = __builtin_amdgcn_ds_read_tr16_b64_v4i16((lds_s16x4_p)(lds + ta + 2048));
          }
        }
        __builtin_amdgcn_sched_barrier(0);
        #pragma unroll
        for (int mbk = 0; mbk < 4; ++mbk) {
          const bf16x8 av = __builtin_shufflevector(r3[jj % 3][2 * mbk], r3[jj % 3][2 * mbk + 1], 0, 1, 2, 3, 4, 5, 6, 7);
          ow[mbk] = __builtin_amdgcn_mfma_f32_16x16x32_bf16(av, pw[jj], ow[mbk], 0, 0, 0);
        }
        __builtin_amdgcn_sched_barrier(0);
      }
    }
    #pragma unroll
    for (int mbk = 0; mbk < 4; ++mbk) {
      const int dh = 16 * mbk + 4 * fq;
      const float g0 = bflo(gv[mbk].x), g1 = bfhi(gv[mbk].x), g2 = bflo(gv[mbk].y), g3 = bfhi(gv[mbk].y);
      const float o0 = oc[mbk][0] * gc + ow[mbk][0] * gw, o1 = oc[mbk][1] * gc + ow[mbk][1] * gw;
      const float o2 = oc[mbk][2] * gc + ow[mbk][2] * gw, o3 = oc[mbk][3] * gc + ow[mbk][3] * gw;
      uint2 ov; ov.x = pk2(o0 * g0, o1 * g1); ov.y = pk2(o2 * g2, o3 * g3);
      *(uint2*)(mb + qtok * D + 256 + h * 64 + dh) = ov;
    }
    __syncthreads();
    if (!has_next) break;
    cur = nxt; task = ntask; ++round;
  }
}

struct ConvTask { int L, t0; size_t tokbase; };
DI ConvTask conv_decode(int task) {
  ConvTask t;
  if (task < 1024) { const int b = task >> 6; t.t0 = (task & 63) * 64; t.L = SEQ; t.tokbase = (size_t)b * SEQ; }
  else { const int t2 = task - 1024; const int b = t2 >> 2; t.t0 = (t2 & 3) * 64; t.L = NCTX; t.tokbase = (size_t)ML + b * NCTX; }
  return t;
}

DI void conv_loop(const Params& P, int wv, int l, int n_conv, int first, char* lds, int max_iters) {
  const u16* z = (const u16*)(P.ws + WS_Z);
  u16* mb = (u16*)(P.ws + WS_HM);
  const int tid = opaque_tid(wv);
  const int G = gridDim.x;
  int task = first, iters = 1;
  if (task >= n_conv) return;
  u16* U = (u16*)lds;
  float* O = (float*)(lds + 49152);

  uint4 pv[6];
  auto load_pq = [&](const ConvTask& t, int tq_) __attribute__((always_inline)) {
    #pragma unroll
    for (int it = 0; it < 6; ++it) {
      const int id = tq_ + it * 512, trow = id >> 5, cgA = id & 31;
      const int tt = t.t0 - 15 + trow;
      const bool ok = (id < 94 * 32) && tt >= 0 && tt < t.L;
      const u16* zr = z + (t.tokbase + (ok ? tt : t.t0)) * ZC;
      pv[it] = *(const uint4*)(zr + Z_CFU + cgA * 8);
    }
  };
  ConvTask cur = conv_decode(task);
  load_pq(cur, tid);

  for (;;) {
    const int L = cur.L, t0 = cur.t0; const size_t tokbase = cur.tokbase;
    int lq = l, tq = tid;
    asm volatile("" : "+s"(lq), "+v"(tq));
    const int c = tq & 255, run = tq >> 8;
    const int cg8 = tq & 31, srun = tq >> 5;
    const int lane = tq & 63, w = tq >> 6;
    #pragma unroll
    for (int it = 0; it < 6; ++it) {
      const int id = tq + it * 512, trow = id >> 5, cgA = id & 31;
      const int tt = t0 - 15 + trow;
      const bool ok = tt >= 0 && tt < L;
      if (id < 94 * 32) {
        uint4 o = pv[it];
        if (!ok) o = make_uint4(0u, 0u, 0u, 0u);
        *(uint4*)(U + trow * 256 + cgA * 8) = o;
      }
    }
    {
    uint4 hv[6], bv[4];
    #pragma unroll
    for (int jj = 0; jj < 6; ++jj) {
      const int tt = t0 + srun * 4 - 1 + jj;
      const bool ok = tt >= 0 && tt < L;
      const u16* zr = z + (tokbase + (ok ? tt : t0)) * ZC;
      hv[jj] = *(const uint4*)(zr + Z_SCV + cg8 * 8);
    }
    #pragma unroll
    for (int i = 0; i < 4; ++i) {
      const u16* zr = z + (tokbase + t0 + srun * 4 + i) * ZC;
      bv[i] = *(const uint4*)(zr + Z_SCG + cg8 * 8);
    }
      const float* wsc = P.conv_sc + (size_t)lq * 3 * 256 + cg8 * 8;
      float w0[8], w1[8], w2[8];
      #pragma unroll
      for (int e = 0; e < 8; ++e) { w0[e] = wsc[e]; w1[e] = wsc[256 + e]; w2[e] = wsc[512 + e]; }
      float v[6][8];
      #pragma unroll
      for (int jj = 0; jj < 6; ++jj) {
        const int tt = t0 + srun * 4 - 1 + jj;
        const bool ok = tt >= 0 && tt < L;
        float hf[8]; unpack8(hv[jj], hf);
        #pragma unroll
        for (int e = 0; e < 8; ++e) v[jj][e] = ok ? hf[e] : 0.f;
      }
      #pragma unroll
      for (int i = 0; i < 4; ++i) {
        const size_t tok = tokbase + t0 + srun * 4 + i;
        float bf[8], of[8]; unpack8(bv[i], bf);
        #pragma unroll
        for (int e = 0; e < 8; ++e)
          of[e] = bf[e] * (w0[e] * v[i][e] + w1[e] * v[i + 1][e] + w2[e] * v[i + 2][e]);
        uint4 ov; ov.x = pk2(of[0], of[1]); ov.y = pk2(of[2], of[3]); ov.z = pk2(of[4], of[5]); ov.w = pk2(of[6], of[7]);
        *(uint4*)(mb + tok * D + cg8 * 8) = ov;
      }
    }

    __syncthreads();

    const int ntask = task + G;
    const bool has_next = (ntask < n_conv) && (iters < max_iters);
    ConvTask nxt = cur;
    if (has_next) { nxt = conv_decode(ntask); load_pq(nxt, tq); }

    {
      const float* wcf = P.conv_cf + (size_t)lq * 31 * 256 + c;
      float wk[31];
      #pragma unroll
      for (int k = 0; k < 31; ++k) wk[k] = wcf[k * 256];
      f32x2 W2[32];
      #pragma unroll
      for (int k = 0; k < 32; ++k) { W2[k][0] = (k < 31) ? wk[k] : 0.f; W2[k][1] = (k > 0) ? wk[k - 1] : 0.f; }
      const float bias = P.conv_cf_b[lq * 256 + c];
      #pragma unroll 1
      for (int ob = 0; ob < 4; ++ob) {
        const int r0 = run * 32 + ob * 8;
        const u16* up = U + r0 * 256 + c;
        f32x2 acc2[4];
        #pragma unroll
        for (int p = 0; p < 4; ++p) { acc2[p][0] = bias; acc2[p][1] = bias; }
        unsigned short raw[38];
        #pragma unroll
        for (int jj = 0; jj < 38; ++jj) raw[jj] = up[jj * 256];
        __builtin_amdgcn_sched_barrier(0);
        #pragma unroll
        for (int jj = 0; jj < 38; ++jj) {
          const float val = __uint_as_float(((unsigned)raw[jj]) << 16);
          f32x2 v2; v2[0] = val; v2[1] = val;
          #pragma unroll
          for (int p = 0; p < 4; ++p) {
            if (jj - 2 * p >= 0 && jj - 2 * p <= 31) acc2[p] = W2[jj - 2 * p] * v2 + acc2[p];
          }
        }
        #pragma unroll
        for (int p = 0; p < 4; ++p) { O[(r0 + 2 * p) * 256 + c] = acc2[p][0]; O[(r0 + 2 * p + 1) * 256 + c] = acc2[p][1]; }
      }
    }
    uint2 zg[8];
    #pragma unroll
    for (int i = 0; i < 8; ++i) zg[i] = *(const uint2*)(z + (tokbase + t0 + w * 8 + i) * ZC + Z_CFG + lane * 4);
    __syncthreads();

    {
      const float4 lg = *(const float4*)(P.ln_cf_g + lq * 256 + lane * 4);
      const float4 lb = *(const float4*)(P.ln_cf_b + lq * 256 + lane * 4);
      float4 xva[8];
      #pragma unroll
      for (int i = 0; i < 8; ++i) xva[i] = *(const float4*)(O + (w * 8 + i) * 256 + lane * 4);
      __builtin_amdgcn_sched_barrier(0);
      #pragma unroll
      for (int i = 0; i < 8; ++i) {
        const int ti = w * 8 + i;
        const float4 xv = xva[i];
        const float s = wave_sum(xv.x + xv.y + xv.z + xv.w);
        const float mu = s * (1.f / 256.f);
        float d0 = xv.x - mu, d1 = xv.y - mu, d2 = xv.z - mu, d3 = xv.w - mu;
        const float q = wave_sum(d0 * d0 + d1 * d1 + d2 * d2 + d3 * d3);
        const float rstd = rsqrtf(q * (1.f / 256.f) + 1e-5f);
        const size_t tok = tokbase + t0 + ti;
        float y0 = silu_f(d0 * rstd * lg.x + lb.x) * bflo(zg[i].x);
        float y1 = silu_f(d1 * rstd * lg.y + lb.y) * bfhi(zg[i].x);
        float y2 = silu_f(d2 * rstd * lg.z + lb.z) * bflo(zg[i].y);
        float y3 = silu_f(d3 * rstd * lg.w + lb.w) * bfhi(zg[i].y);
        uint2 ov; ov.x = pk2(y0, y1); ov.y = pk2(y2, y3);
        *(uint2*)(mb + tok * D + 768 + lane * 4) = ov;
      }
    }
    if (!has_next) break;
    cur = nxt; task = ntask; ++iters;
  }
  __syncthreads();
}

DI void phase_mixer(const Params& P, int wv, int l, char* lds, int which = 3) {
  const bool last = (l == DEPTH - 1);
  const int n_attn = last ? 4096 : 4352;
  const int n_conv = last ? 1024 : 1088;
  const int G = gridDim.x;
  const int nr = (n_attn + G - 1) / G;
  const int L = logical_block();
  int l2 = l;
  asm volatile("" : "+s"(l2));
  if (which & 1) attn_loop(P, wv, l2, n_attn, lds, 0, nr);
  asm volatile("" : "+s"(l2));
  if (which & 2) conv_loop(P, wv, l2, n_conv, L, lds, 1000);
}

#define XB_TMO      128
#define XB_XCNT(j)  (256  + 64 * (j))
#define XB_XSUB(j)  (1280 + 64 * (j))
#define XB_XGEN(j)  (2304 + 64 * (j))
#define XB_TOP      3328
#define XB_TOPGEN   3392
#define XCD_BAR_WORDS 3456
#define XB_SPIN_CAP (1u << 18)
DI unsigned xb_ld(unsigned* p)              { return __hip_atomic_load(p, __ATOMIC_RELAXED, __HIP_MEMORY_SCOPE_AGENT); }
DI unsigned xb_add(unsigned* p, unsigned v) { return __hip_atomic_fetch_add(p, v, __ATOMIC_RELAXED, __HIP_MEMORY_SCOPE_AGENT); }
DI unsigned xb_xcc_id() { return (unsigned)__builtin_amdgcn_s_getreg((3 << 11) | 20) & 0xFu; }
#define XB_SPIN(cond, bar) do { unsigned _sp = 0; while (cond) { __builtin_amdgcn_s_sleep(1); \
    if ((++_sp & 255u) == 0u) { if (xb_ld(&(bar)[XB_TMO])) break; if (_sp > XB_SPIN_CAP) { atomicAdd(&(bar)[XB_TMO], 1u); break; } } } } while (0)
struct XcdBarrier { unsigned* bar; unsigned x; volatile LAS unsigned* st; };
DI XcdBarrier xcd_barrier_post(unsigned* bar, volatile LAS unsigned* st) {
  XcdBarrier b; b.bar = bar; b.x = xb_xcc_id(); b.st = st;
  if (threadIdx.x == 0) (void)xb_add(&bar[XB_XCNT(b.x)], 1u);
  return b;
}
DI void xcd_barrier_complete(unsigned* bar, unsigned x, unsigned& nloc, unsigned& nx) {
  const unsigned G = gridDim.x * gridDim.y * gridDim.z;
  unsigned sum, cnt, mine, sp = 0u;
  for (;;) {
    sum = 0u; cnt = 0u; mine = 0u;
    #pragma unroll
    for (unsigned j = 0; j < 16; ++j) { const unsigned c = xb_ld(&bar[XB_XCNT(j)]); sum += c; cnt += (c > 0u) ? 1u : 0u; mine = (j == x) ? c : mine; }
    if (sum == G) break;
    __builtin_amdgcn_s_sleep(1);
    if ((++sp & 255u) == 0u) { if (xb_ld(&bar[XB_TMO])) break; if (sp > XB_SPIN_CAP) { atomicAdd(&bar[XB_TMO], 1u); break; } }
  }
  nloc = mine > 0u ? mine : 1u; nx = cnt > 0u ? cnt : 1u;
}
DI void xcd_barrier(const XcdBarrier& b) {
  asm volatile("s_waitcnt vmcnt(0)" ::: "memory");
  __syncthreads();
  if (threadIdx.x == 0) {
    unsigned* bar = b.bar;
    __builtin_amdgcn_s_waitcnt(0);
    unsigned nloc = b.st[0], nx = b.st[1];
    if (nloc == 0u) { xcd_barrier_complete(bar, b.x, nloc, nx); b.st[0] = nloc; b.st[1] = nx; }
    const unsigned old = xb_add(&bar[XB_XSUB(b.x)], 1u);
    const unsigned gen = old / nloc;
    if (old + 1u == (gen + 1u) * nloc) {
      __builtin_amdgcn_fence(__ATOMIC_RELEASE, "agent");
      asm volatile("s_waitcnt vmcnt(0)" ::: "memory");
      const unsigned og = xb_add(&bar[XB_TOP], 1u);
      const unsigned tg = og / nx;
      if (og + 1u == (tg + 1u) * nx) xb_add(&bar[XB_TOPGEN], 1u);
      else XB_SPIN(xb_ld(&bar[XB_TOPGEN]) == tg, bar);
      __builtin_amdgcn_fence(__ATOMIC_ACQUIRE, "agent");
      xb_add(&bar[XB_XGEN(b.x)], 1u);
      asm volatile("s_waitcnt vmcnt(0)" ::: "memory");
    } else {
      XB_SPIN(xb_ld(&bar[XB_XGEN(b.x)]) == gen, bar);
      __builtin_amdgcn_fence(__ATOMIC_ACQUIRE, "agent");
      asm volatile("s_waitcnt vmcnt(0)" ::: "memory");
    }
  }
  __syncthreads();
}

constexpr int NPHASE = 18;
template <bool COOP>
__global__ void __launch_bounds__(512) mk_kernel(Params P, int ph_lo, int ph_hi) {
  extern __shared__ __attribute__((aligned(16))) char lds[];
  const int wv = __builtin_amdgcn_readfirstlane((int)(threadIdx.x >> 6));
  XcdBarrier xb;
  if (COOP) {
    volatile LAS unsigned* st = (volatile LAS unsigned*)((LAS char*)lds + LDS_WORK);
    if (threadIdx.x == 0) { st[0] = 0u; st[1] = 0u; }
    __syncthreads();
    xb = xcd_barrier_post((unsigned*)(P.ws + WS_BAR), st);
  }
  for (int ph = ph_lo; ph < ph_hi; ++ph) {
    if (ph == 0) phase0(P, wv, lds);
    else if (ph == NPHASE - 1) phase_resnorm(P, wv, DEPTH);
    else {
      const int l = (ph - 1) >> 2, s = (ph - 1) & 3;
      if (s == 0) { phase_resnorm(P, wv, l); }
      else if (s == 1) { phase_inproj(P, wv, l, lds); if (PROBE == 2) { cg::this_grid().sync(); phase_inproj(P, wv, l, lds); } }
      else if (s == 2) { phase_mixer(P, wv, l, lds); if (PROBE == 4) { cg::this_grid().sync(); phase_mixer(P, wv, l, lds, 1); } if (PROBE == 5) { cg::this_grid().sync(); phase_mixer(P, wv, l, lds, 2); } }
      else { phase_outproj(P, wv, l, lds); if (PROBE == 6) { cg::this_grid().sync(); phase_outproj(P, wv, l, lds); } }
    }
    if (COOP) { if (ph + 1 < ph_hi) {
      if (ph_hi > NPHASE) cg::this_grid().sync(); else xcd_barrier(xb);
    } }
  }
}

extern "C" void kernel_launch(void* const* d_in, const int* in_sizes, int n_in, void* d_out, int out_size,
                              void* d_ws, size_t ws_size, hipStream_t stream) {
  static int grid = 0;
  if (grid == 0) {
    if (n_in != 16 || out_size != ML * D || ws_size < WS_END) {
      fprintf(stderr, "kernel_launch: unexpected shapes n_in %d out %d ws %zu (need %zu)\n", n_in, out_size, ws_size, (size_t)WS_END);
      grid = -1; return;
    }
    int dev = 0, cus = 0, per_cu = 0;
    hipGetDevice(&dev);
    hipDeviceGetAttribute(&cus, hipDeviceAttributeMultiprocessorCount, dev);
    const void* fn = MK_COOP ? (const void*)mk_kernel<true> : (const void*)mk_kernel<false>;
    if (hipFuncSetAttribute(fn, hipFuncAttributeMaxDynamicSharedMemorySize, LDS_BYTES) != hipSuccess) {
      fprintf(stderr, "kernel_launch: hipFuncSetAttribute failed\n"); grid = -1; return;
    }
    if (hipOccupancyMaxActiveBlocksPerMultiprocessor(&per_cu, fn, 512, LDS_BYTES) != hipSuccess || per_cu < 1) {
      fprintf(stderr, "kernel_launch: occupancy query gave %d\n", per_cu); per_cu = 1;
    }
    (void)hipGetLastError();
    grid = cus * 1;
  }
  if (grid < 0) return;
  Params p{};
  p.x = (const float*)d_in[0]; p.c = (const float*)d_in[1]; p.ctx = (const float*)d_in[2]; p.c_ctx = (const float*)d_in[3];
  p.norm_g = (const float*)d_in[4]; p.w_ada = (const float*)d_in[5]; p.b_ada = (const float*)d_in[6]; p.w_in = (const float*)d_in[7];
  p.conv_sc = (const float*)d_in[8]; p.rpb = (const float*)d_in[9]; p.conv_cf = (const float*)d_in[10]; p.conv_cf_b = (const float*)d_in[11];
  p.ln_cf_g = (const float*)d_in[12]; p.ln_cf_b = (const float*)d_in[13]; p.w_out = (const float*)d_in[14]; p.final_g = (const float*)d_in[15];
  p.out = (float*)d_out; p.ws = (unsigned char*)d_ws;
  hipMemsetAsync((char*)d_ws + WS_MOD, 0, MOD_BYTES + XCD_BAR_WORDS * 4, stream);
#if MK_COOP
  int lo = 0, hi = NPHASE;
  void* args[] = {&p, &lo, &hi};
  hipError_t e = hipLaunchCooperativeKernel((const void*)mk_kernel<true>, dim3(grid), dim3(512), args, LDS_BYTES, stream);
  if (e != hipSuccess) fprintf(stderr, "cooperative launch failed: %s (grid %d)\n", hipGetErrorString(e), grid);
#else
  for (int ph = 0; ph < NPHASE; ++ph)
    hipLaunchKernelGGL(mk_kernel<false>, dim3(grid), dim3(512), LDS_BYTES, stream, p, ph, ph + 1);
#endif
}
```

```cpp
#include <hip/hip_runtime.h>
#include <hip/hip_cooperative_groups.h>
#include <cstdio>
namespace cg = cooperative_groups;

#ifndef PROBE
#define PROBE 0
#endif
#ifndef MK_COOP
#define MK_COOP 1
#endif

typedef unsigned short u16;
using bf16x8 = __attribute__((ext_vector_type(8))) short;
using s16x4  = __attribute__((ext_vector_type(4))) short;
using f32x4  = __attribute__((ext_vector_type(4))) float;
using u32x4  = __attribute__((ext_vector_type(4))) unsigned;
using f32x2  = __attribute__((ext_vector_type(2))) float;
using u32x2  = __attribute__((ext_vector_type(2))) unsigned;
typedef __attribute__((ext_vector_type(2))) __bf16 bf2_t;
#define DI __device__ __forceinline__

constexpr int D = 1024, NB = 16, SEQ = 4096, NCTX = 256, DP = 3840, DEPTH = 4;
constexpr int ZC = 3072, Z_SCV = 0, Z_SCG = 256, Z_Q = 512, Z_K = 1024, Z_V = 1536, Z_NG = 2048, Z_CFU = 2560, Z_CFG = 2816;
constexpr int ML = NB * SEQ;
constexpr int MC = NB * NCTX;
constexpr int MT = ML + MC;
constexpr int NTT = MT / 256;
constexpr int LDS_WORK = 131072;
constexpr int LDS_BYTES = LDS_WORK + 16;

constexpr size_t WS_WIN  = 0;
constexpr size_t WS_WOUT = WS_WIN + (size_t)DEPTH * DP * D * 2;
constexpr size_t WS_MOD  = WS_WOUT + (size_t)DEPTH * D * D * 2;
constexpr size_t MOD_BYTES = (size_t)DEPTH * 17 * 3072 * 4;
constexpr size_t WS_BAR  = WS_MOD + MOD_BYTES;
constexpr size_t WS_CTX  = WS_MOD + 1048576;
constexpr size_t WS_HM   = WS_CTX + (size_t)MC * D * 4;
constexpr size_t WS_Z    = WS_HM + (size_t)MT * D * 2;
constexpr size_t WS_Y    = WS_Z + (size_t)MT * DP * 2;
constexpr size_t WS_END  = WS_Y + (size_t)MT * D * 2;

struct Params {
  const float *x, *c, *ctx, *c_ctx, *norm_g, *w_ada, *b_ada, *w_in, *conv_sc, *rpb, *conv_cf, *conv_cf_b, *ln_cf_g, *ln_cf_b, *w_out, *final_g;
  float* out;
  unsigned char* ws;
};

DI float fexp2(float v) { return __builtin_amdgcn_exp2f(v); }
DI float sigmoid_f(float v) { return __builtin_amdgcn_rcpf(1.f + fexp2(-1.4426950408889634f * v)); }
DI float silu_f(float v) { return v * sigmoid_f(v); }
DI unsigned pk2(float a, float b) { bf2_t v; v[0] = (__bf16)a; v[1] = (__bf16)b; return __builtin_bit_cast(unsigned, v); }
DI float bflo(unsigned w) { return __uint_as_float(w << 16); }
DI float bfhi(unsigned w) { return __uint_as_float(w & 0xffff0000u); }
DI void unpack8(const uint4& v, float* f) {
  f[0] = bflo(v.x); f[1] = bfhi(v.x); f[2] = bflo(v.y); f[3] = bfhi(v.y);
  f[4] = bflo(v.z); f[5] = bfhi(v.z); f[6] = bflo(v.w); f[7] = bfhi(v.w);
}
DI int opaque_tid(int wv) {
  unsigned m = ~0u;
  asm volatile("" : "+s"(m));
  int t = wv * 64 + (int)__builtin_amdgcn_mbcnt_hi(m, __builtin_amdgcn_mbcnt_lo(m, 0u));
  asm volatile("" : "+v"(t)); return t;
}
DI void st16_wt(void* p, const uint4& v) {
  u32x4 d; d[0] = v.x; d[1] = v.y; d[2] = v.z; d[3] = v.w;
  asm volatile("global_store_dwordx4 %0, %1, off sc1" :: "v"(p), "v"(d) : "memory");
}
template <int CTRL, int RMASK> DI float dpp0(float x) { return __int_as_float(__builtin_amdgcn_update_dpp(0, __float_as_int(x), CTRL, RMASK, 0xf, false)); }
DI float wave_sum(float x) {
  x += dpp0<0xB1, 0xf>(x);
  x += dpp0<0x4E, 0xf>(x);
  x += dpp0<0x124, 0xf>(x);
  x += dpp0<0x128, 0xf>(x);
  x += dpp0<0x142, 0xa>(x);
  x += dpp0<0x143, 0xc>(x);
  return __int_as_float(__builtin_amdgcn_readlane(__float_as_int(x), 63));
}
DI int clampi(int v, int lo, int hi) { return v < lo ? lo : (v > hi ? hi : v); }

#define LAS __attribute__((address_space(3)))
constexpr int BM = 256, BK = 64, HALF = 128, HTB = HALF * BK * 2;
DI int lds_byte(int r, int c) { const int st = (r >> 4) * 2 + (c >> 5), rr = r & 15, cc = c & 31, ob = rr * 64 + cc * 2; return st * 1024 + (ob ^ (((ob >> 9) & 1) << 5)); }
DI void stage_rc(int b, int& R, int& C) { const int st = b / 1024, sb = b % 1024, swz = sb ^ (((sb >> 9) & 1) << 5); R = (st >> 1) * 16 + swz / 64; C = (st & 1) * 32 + (swz % 64) / 2; }
DI int perm32(int rho) { const int n = rho >> 4, i = rho & 15; return 8 * (i >> 2) + 4 * n + (i & 3); }

DI int win_src_col(int n) {
  const int pn = n >> 8, r = n & 255, half = r >> 7, q = r & 127;
  if (pn == 0 || pn == 1) return (half ? 512 : 0) + pn * 128 + q;
  if (pn == 2 || pn == 3) return (half ? 768 : 256) + (pn - 2) * 128 + q;
  if (pn == 12 || pn == 13) return (half ? 3328 : 3072) + (pn - 12) * 128 + q;
  return n;
}

DI int logical_block() {
  int g = gridDim.x;
  if ((g & 7) == 0) return (blockIdx.x & 7) * (g >> 3) + (blockIdx.x >> 3);
  return blockIdx.x;
}

template <bool PERM, class Epi>
DI void gemm_phase(const Params& P, int wv, const u16* __restrict__ Aact, const u16* __restrict__ Wt, int ntiles, int nct, LAS unsigned char* lds, Epi&& E) {
  constexpr int K = 1024, nt = K / BK;
  const int tid = opaque_tid(wv), wid = tid >> 6, lane = tid & 63, wr = wid >> 2, wc = wid & 3, fr = lane & 15, fq = lane >> 4;
  const int G = gridDim.x;
  unsigned voffA[2], voffB[2];
  #pragma unroll
  for (int i = 0; i < 2; ++i) { int R, C; stage_rc(tid * 16 + i * 8192, R, C); const int Rb = PERM ? ((R & ~31) + perm32(R & 31)) : R;
    voffA[i] = (unsigned)(R * K + C) * 2u; voffB[i] = (unsigned)(Rb * K + C) * 2u; }
  const size_t kstep = (size_t)(BK * 2), hstep = (size_t)HALF * K * 2, tstep = 2 * hstep;
  const unsigned ldsw = (unsigned)wid * 1024u;
  const int aoff = lds_byte(wr * 64 + fr, fq * 8), boff = lds_byte(wc * 32 + fr, fq * 8);
  #define G_SA(b, h) (((b) * 2 + (h)) * HTB)
  #define G_SB(b, h) ((4 + (b) * 2 + (h)) * HTB)
  #define G_STAGE(bufoff, gbase, voff) do { _Pragma("unroll") for (int _i = 0; _i < 2; ++_i) \
      __builtin_amdgcn_global_load_lds((const unsigned*)((const char*)(gbase) + (voff)[_i]), (LAS unsigned*)(lds + (bufoff) + ldsw + _i * 8192), 16, 0, 0); } while (0)
  #define G_LDA(dst, b, h) do { _Pragma("unroll") for (int m = 0; m < 4; ++m) _Pragma("unroll") for (int k = 0; k < 2; ++k) dst[m][k] = *(const LAS bf16x8*)(lds + G_SA(b, h) + aoff + m * 2048 + k * 1024); } while (0)
  #define G_LDB(dst, b, h) do { _Pragma("unroll") for (int n = 0; n < 2; ++n) _Pragma("unroll") for (int k = 0; k < 2; ++k) dst[n][k] = *(const LAS bf16x8*)(lds + G_SB(b, h) + boff + n * 2048 + k * 1024); } while (0)
  #define G_MMA(ai, bj, At, Bt) do { __builtin_amdgcn_s_setprio(1); _Pragma("unroll") for (int m = 0; m < 4; ++m) _Pragma("unroll") for (int n = 0; n < 2; ++n) _Pragma("unroll") for (int k = 0; k < 2; ++k) \
      acc[ai][bj][m][n] = __builtin_amdgcn_mfma_f32_16x16x32_bf16(Bt[n][k], At[m][k], acc[ai][bj][m][n], 0, 0, 0); __builtin_amdgcn_s_setprio(0); } while (0)
  #define G_WAIT_V(n) asm volatile("s_waitcnt vmcnt(" #n ")" ::: "memory")
  #define G_WAIT_L(n) asm volatile("s_waitcnt lgkmcnt(" #n ")" ::: "memory")
  #define G_BAR __builtin_amdgcn_s_barrier()
  #define G_SCHED __builtin_amdgcn_sched_barrier(0)
  const int ntm = ntiles / nct;
  auto unit = [&](int i, int& pm, int& pn) __attribute__((always_inline)) -> bool {
    const int Lg = i * G + blockIdx.x;
    if (Lg >= ntiles) return false;
    int wg = Lg;
    { const int q = ntiles >> 3, r = ntiles & 7, xcd = wg & 7, off = wg >> 3; wg = (xcd < r ? xcd * (q + 1) : r * (q + 1) + (xcd - r) * q) + off; }
    const int nig = 8 * nct, gid = wg / nig, fm = gid * 8, gsz = (ntm - fm) < 8 ? (ntm - fm) : 8;
    const int rem = wg - gid * nig;
    pm = fm + rem % gsz; pn = rem / gsz; return true;
  };
  int ui = 0, cpm, cpn, npm = 0, npn = 0;
  if (!unit(0, cpm, cpn)) return;
  f32x4 acc[2][2][4][2];
  #pragma unroll
  for (int a = 0; a < 2; ++a)
  #pragma unroll
    for (int b = 0; b < 2; ++b)
  #pragma unroll
      for (int m = 0; m < 4; ++m)
  #pragma unroll
        for (int n = 0; n < 2; ++n) acc[a][b][m][n] = (f32x4){0.f, 0.f, 0.f, 0.f};
  bf16x8 At[4][2], B0[2][2], B1[2][2];
  const char* cA = (const char*)Aact + (size_t)cpm * tstep; const char* cB = (const char*)Wt + (size_t)cpn * tstep;
  G_WAIT_V(0);
  G_STAGE(G_SB(0, 0), cB, voffB); G_STAGE(G_SA(0, 0), cA, voffA); G_STAGE(G_SB(0, 1), cB + hstep, voffB); G_STAGE(G_SA(0, 1), cA + hstep, voffA);
  if (wr == 1) G_BAR;
  G_WAIT_V(4); G_BAR;
  G_STAGE(G_SB(1, 0), cB + kstep, voffB); G_STAGE(G_SA(1, 0), cA + kstep, voffA); G_STAGE(G_SB(1, 1), cB + hstep + kstep, voffB);
  G_WAIT_V(6); G_BAR;
  for (;;) {
    bool has_next;
    has_next = unit(ui + 1, npm, npn);
    const char* nA = has_next ? (const char*)Aact + (size_t)npm * tstep : cA; const char* nB = has_next ? (const char*)Wt + (size_t)npn * tstep : cB;
    for (int t = 0; t < nt; t += 2) {
      const bool last = (t == nt - 2);
      const char* a1 = cA + (size_t)(t + 1) * kstep;
      const char* a2 = last ? nA : cA + (size_t)(t + 2) * kstep; const char* b2 = last ? nB : cB + (size_t)(t + 2) * kstep;
      const char* a3 = a2 + kstep; const char* b3 = b2 + kstep;
      G_LDB(B0, 0, 0); G_SCHED; G_LDA(At, 0, 0); G_STAGE(G_SA(1, 1), a1 + hstep, voffA);
      G_WAIT_L(8); G_BAR; G_WAIT_L(0); G_MMA(0, 0, At, B0); G_BAR; G_SCHED;
      G_LDB(B1, 0, 1); G_STAGE(G_SB(0, 0), b2, voffB);
      G_BAR; G_WAIT_L(0); G_MMA(0, 1, At, B1); G_BAR;
      G_LDA(At, 0, 1); G_STAGE(G_SA(0, 0), a2, voffA);
      G_BAR; G_WAIT_L(0); G_MMA(1, 0, At, B0); G_BAR; G_SCHED;
      G_STAGE(G_SB(0, 1), b2 + hstep, voffB);
      G_WAIT_V(6); G_BAR; G_MMA(1, 1, At, B1); G_BAR;
      G_LDB(B0, 1, 0); G_SCHED; G_LDA(At, 1, 0); G_STAGE(G_SA(0, 1), a2 + hstep, voffA);
      G_WAIT_L(8); G_BAR; G_WAIT_L(0); G_MMA(0, 0, At, B0); G_BAR; G_SCHED;
      G_LDB(B1, 1, 1); G_STAGE(G_SB(1, 0), b3, voffB);
      G_BAR; G_WAIT_L(0); G_MMA(0, 1, At, B1); G_BAR;
      G_LDA(At, 1, 1); G_STAGE(G_SA(1, 0), a3, voffA);
      G_BAR; G_WAIT_L(0); G_MMA(1, 0, At, B0); G_BAR; G_SCHED;
      G_STAGE(G_SB(1, 1), b3 + hstep, voffB);
      G_WAIT_V(6); G_BAR; G_MMA(1, 1, At, B1); G_BAR;
    }
    E(acc, cpm, cpn, wr, wc, fr, fq);
    if (!has_next) break;
    #pragma unroll
    for (int a = 0; a < 2; ++a)
    #pragma unroll
      for (int b = 0; b < 2; ++b)
    #pragma unroll
        for (int m = 0; m < 4; ++m)
    #pragma unroll
          for (int n = 0; n < 2; ++n) acc[a][b][m][n] = (f32x4){0.f, 0.f, 0.f, 0.f};
    cpm = npm; cpn = npn; cA = nA; cB = nB; ++ui;
  }
  G_WAIT_V(0);
  if (wr == 0) G_BAR;
  G_BAR;
  #undef G_SA
  #undef G_SB
  #undef G_STAGE
  #undef G_LDA
  #undef G_LDB
  #undef G_MMA
  #undef G_WAIT_V
  #undef G_WAIT_L
  #undef G_BAR
  #undef G_SCHED
}

DI void transpose_tiles(const Params& P, int tid, char* lds, int l, int first, int stride) {
  u16* winT = (u16*)(P.ws + WS_WIN) + (size_t)l * DP * D;
  u16* woutT = (u16*)(P.ws + WS_WOUT) + (size_t)l * D * D;
  float* tile = (float*)lds;
  for (int t2 = first; t2 < 960 + 256; t2 += stride) {
    const float* src; u16* dst; int N, kt, ntile, n_src;
    if (t2 < 960) { kt = t2 / 60; ntile = t2 % 60; N = DP; src = P.w_in + (size_t)l * D * DP; dst = winT; n_src = win_src_col(ntile * 64); }
    else { const int r2 = t2 - 960; kt = r2 >> 4; ntile = r2 & 15; N = D; src = P.w_out + (size_t)l * D * D; dst = woutT; n_src = ntile * 64; }
    const int k0 = kt * 64, n0 = ntile * 64;
    {
      const int r = tid >> 4, c4 = tid & 15;
      #pragma unroll
      for (int hh = 0; hh < 2; ++hh) {
        float4 v = *(const float4*)(src + (size_t)(k0 + r + hh * 32) * N + n_src + c4 * 4);
        float* tp = tile + (r + hh * 32) * 65 + c4 * 4;
        tp[0] = v.x; tp[1] = v.y; tp[2] = v.z; tp[3] = v.w;
      }
    }
    __syncthreads();
    {
      const int n = tid >> 3, kc = tid & 7;
      float f[8];
      #pragma unroll
      for (int e = 0; e < 8; ++e) f[e] = tile[(kc * 8 + e) * 65 + n];
      uint4 o; o.x = pk2(f[0], f[1]); o.y = pk2(f[2], f[3]); o.z = pk2(f[4], f[5]); o.w = pk2(f[6], f[7]);
      *(uint4*)(dst + (size_t)(n0 + n) * D + k0 + kc * 8) = o;
    }
    __syncthreads();
  }
}

DI void phase0(const Params& P, int wv, char* lds) {
  const int tid = opaque_tid(wv);
  float* mod = (float*)(P.ws + WS_MOD);
  constexpr int NG = 192;
  for (int task = blockIdx.x; task < NG; task += gridDim.x) {
    const int l = task / 48, rem = task % 48, nc = rem >> 3, ks = rem & 7;
    float* s = (float*)lds;
    for (int id = tid; id < 17 * 128; id += 512) {
      int r = id >> 7, kk = id & 127;
      float v = (r < 16) ? P.c[r * D + ks * 128 + kk] : P.c_ctx[ks * 128 + kk];
      s[id] = silu_f(v);
    }
    __syncthreads();
    const int n = nc * 512 + tid;
    float acc[17];
    #pragma unroll
    for (int r = 0; r < 17; ++r) acc[r] = 0.f;
    const float* wp = P.w_ada + ((size_t)l * D + ks * 128) * 3072 + n;
    for (int k4 = 0; k4 < 32; ++k4) {
      float w0 = wp[(size_t)(k4 * 4 + 0) * 3072], w1 = wp[(size_t)(k4 * 4 + 1) * 3072];
      float w2 = wp[(size_t)(k4 * 4 + 2) * 3072], w3 = wp[(size_t)(k4 * 4 + 3) * 3072];
      #pragma unroll
      for (int r = 0; r < 17; ++r) {
        float4 sv = *(const float4*)(s + r * 128 + k4 * 4);
        acc[r] += sv.x * w0 + sv.y * w1 + sv.z * w2 + sv.w * w3;
      }
    }
    const float bias = (ks == 0) ? P.b_ada[l * 3072 + n] : 0.f;
    #pragma unroll
    for (int r = 0; r < 17; ++r) atomicAdd(mod + ((size_t)l * 17 + r) * 3072 + n, acc[r] + bias);
    __syncthreads();
  }
  transpose_tiles(P, tid, lds, 0, (blockIdx.x + gridDim.x - NG % gridDim.x) % gridDim.x, gridDim.x);
}

DI void phase_resnorm(const Params& P, int wv, int l) {
  const int tid = opaque_tid(wv), lane = tid & 63;
  const float* modl = (const float*)(P.ws + WS_MOD) + (size_t)(l < DEPTH ? l : 0) * 17 * 3072;
  const float* modp = (const float*)(P.ws + WS_MOD) + (size_t)(l > 0 ? l - 1 : 0) * 17 * 3072;
  float* ctxs = (float*)(P.ws + WS_CTX);
  u16* h = (u16*)(P.ws + WS_HM);
  const u16* y = (const u16*)(P.ws + WS_Y);
  const bool fin = (l == DEPTH);
  const float* g = fin ? P.final_g : P.norm_g + l * D;
  const int nrows = fin ? ML : MT;
  const int nw = gridDim.x * 8;
  float4 gg[4];
  #pragma unroll
  for (int i = 0; i < 4; ++i) gg[i] = *(const float4*)(g + (i * 64 + lane) * 4);
  for (int row0 = blockIdx.x * 8 + wv; row0 < nrows; row0 += 2 * nw) {
    float4 v[2][4], gt[2][4], sh[2][4], sc[2][4];
    uint2 yv[2][4];
    float* dst[2]; bool ok[2];
    #pragma unroll
    for (int k = 0; k < 2; ++k) {
      const int row = row0 + k * nw;
      ok[k] = row < nrows;
      const int rw = ok[k] ? row : row0;
      const float* src; int rr;
      if (rw < ML) { src = (l <= 1 ? P.x : P.out) + (size_t)rw * D; dst[k] = P.out + (size_t)rw * D; rr = rw >> 12; }
      else { src = (l <= 1 ? P.ctx : ctxs) + (size_t)(rw - ML) * D; dst[k] = ctxs + (size_t)(rw - ML) * D; rr = 16; }
      #pragma unroll
      for (int i = 0; i < 4; ++i) { const f32x4 t = __builtin_nontemporal_load((const f32x4*)(src + (i * 64 + lane) * 4)); v[k][i] = make_float4(t[0], t[1], t[2], t[3]); }
      if (l > 0) {
        #pragma unroll
        for (int i = 0; i < 4; ++i) {
          { const u32x2 t = __builtin_nontemporal_load((const u32x2*)(y + (size_t)rw * D + (i * 64 + lane) * 4)); yv[k][i] = make_uint2(t[0], t[1]); }
          gt[k][i] = *(const float4*)(modp + rr * 3072 + 2048 + (i * 64 + lane) * 4);
        }
      }
      if (!fin) {
        #pragma unroll
        for (int i = 0; i < 4; ++i) {
          sh[k][i] = *(const float4*)(modl + rr * 3072 + (i * 64 + lane) * 4);
          sc[k][i] = *(const float4*)(modl + rr * 3072 + 1024 + (i * 64 + lane) * 4);
        }
      }
    }
    __builtin_amdgcn_sched_barrier(0);
    #pragma unroll
    for (int k = 0; k < 2; ++k) {
      if (!ok[k]) continue;
      const int row = row0 + k * nw;
      float ss = 0.f;
      if (l > 0) {
        #pragma unroll
        for (int i = 0; i < 4; ++i) {
          v[k][i].x += gt[k][i].x * bflo(yv[k][i].x); v[k][i].y += gt[k][i].y * bfhi(yv[k][i].x);
          v[k][i].z += gt[k][i].z * bflo(yv[k][i].y); v[k][i].w += gt[k][i].w * bfhi(yv[k][i].y);
          if (!fin) { f32x4 t; t[0] = v[k][i].x; t[1] = v[k][i].y; t[2] = v[k][i].z; t[3] = v[k][i].w; __builtin_nontemporal_store(t, (f32x4*)(dst[k] + (i * 64 + lane) * 4)); }
        }
      }
      #pragma unroll
      for (int i = 0; i < 4; ++i) ss += v[k][i].x * v[k][i].x + v[k][i].y * v[k][i].y + v[k][i].z * v[k][i].z + v[k][i].w * v[k][i].w;
      ss = wave_sum(ss);
      const float rstd = rsqrtf(ss * (1.f / D) + 1e-6f);
      if (fin) {
        #pragma unroll
        for (int i = 0; i < 4; ++i) {
          const int c = (i * 64 + lane) * 4;
          float4 o; o.x = v[k][i].x * rstd * gg[i].x; o.y = v[k][i].y * rstd * gg[i].y; o.z = v[k][i].z * rstd * gg[i].z; o.w = v[k][i].w * rstd * gg[i].w;
          *(float4*)(dst[k] + c) = o;
        }
      } else {
        #pragma unroll
        for (int i = 0; i < 4; ++i) {
          const int c = (i * 64 + lane) * 4;
          const float a0 = v[k][i].x * rstd * gg[i].x * (1.f + sc[k][i].x) + sh[k][i].x;
          const float a1 = v[k][i].y * rstd * gg[i].y * (1.f + sc[k][i].y) + sh[k][i].y;
          const float a2 = v[k][i].z * rstd * gg[i].z * (1.f + sc[k][i].z) + sh[k][i].z;
          const float a3 = v[k][i].w * rstd * gg[i].w * (1.f + sc[k][i].w) + sh[k][i].w;
          uint2 o; o.x = pk2(a0, a1); o.y = pk2(a2, a3);
          *(uint2*)(h + (size_t)row * D + c) = o;
        }
      }
    }
  }
}

DI void phase_inproj(const Params& P, int wv, int l, char* lds) {
  const u16* W = (const u16*)(P.ws + WS_WIN) + (size_t)l * DP * D;
  const u16* h = (const u16*)(P.ws + WS_HM);
  u16* z = (u16*)(P.ws + WS_Z);
  constexpr int NCT = DP / 256;
  gemm_phase<true>(P, wv, h, W, NTT * NCT, NCT, (LAS unsigned char*)lds,
    [&](const f32x4 (&acc)[2][2][4][2], int pm, int pn, int wr, int wc, int fr, int fq) __attribute__((always_inline)) {
      const int row0 = pm * BM + wr * 64 + fr, cw = wc * 32 + 8 * fq;
      if (pn >= 4 && pn < 10) {
        u16* zp = z + Z_Q + (pn - 4) * 256 + cw;
        #pragma unroll
        for (int ai = 0; ai < 2; ++ai)
        #pragma unroll
          for (int m = 0; m < 4; ++m) {
            u16* rowp = zp + (size_t)(row0 + ai * HALF + m * 16) * ZC;
            #pragma unroll
            for (int bj = 0; bj < 2; ++bj) {
              const f32x4 v0 = acc[ai][bj][m][0], v1 = acc[ai][bj][m][1];
              uint4 o; o.x = pk2(v0[0], v0[1]); o.y = pk2(v0[2], v0[3]); o.z = pk2(v1[0], v1[1]); o.w = pk2(v1[2], v1[3]);
              *(uint4*)(rowp + bj * HALF) = o;
            }
          }
      } else if (pn == 10 || pn == 11 || pn == 14) {
        u16* zp = z + (pn == 14 ? Z_CFG : Z_NG + (pn - 10) * 256) + cw;
        #pragma unroll
        for (int ai = 0; ai < 2; ++ai)
        #pragma unroll
          for (int m = 0; m < 4; ++m) {
            u16* rowp = zp + (size_t)(row0 + ai * HALF + m * 16) * ZC;
            #pragma unroll
            for (int bj = 0; bj < 2; ++bj) {
              const f32x4 v0 = acc[ai][bj][m][0], v1 = acc[ai][bj][m][1];
              uint4 o; o.x = pk2(silu_f(v0[0]), silu_f(v0[1])); o.y = pk2(silu_f(v0[2]), silu_f(v0[3]));
              o.z = pk2(silu_f(v1[0]), silu_f(v1[1])); o.w = pk2(silu_f(v1[2]), silu_f(v1[3]));
              *(uint4*)(rowp + bj * HALF) = o;
            }
          }
      } else {
        const int mode = (pn < 2) ? 0 : (pn < 4 ? 1 : 2);
        const int ob = (pn < 2) ? Z_SCV + pn * 128 : (pn < 4 ? Z_SCG + (pn - 2) * 128 : Z_CFU + (pn - 12) * 128);
        u16* zp = z + ob + cw;
        #pragma unroll
        for (int ai = 0; ai < 2; ++ai)
        #pragma unroll
          for (int m = 0; m < 4; ++m) {
            float o8[8];
            #pragma unroll
            for (int n = 0; n < 2; ++n)
            #pragma unroll
              for (int j = 0; j < 4; ++j) {
                const float a = acc[ai][0][m][n][j], b = acc[ai][1][m][n][j];
                o8[n * 4 + j] = a * (mode == 0 ? b : (mode == 1 ? silu_f(b) : sigmoid_f(b)));
              }
            uint4 o; o.x = pk2(o8[0], o8[1]); o.y = pk2(o8[2], o8[3]); o.z = pk2(o8[4], o8[5]); o.w = pk2(o8[6], o8[7]);
            *(uint4*)(zp + (size_t)(row0 + ai * HALF + m * 16) * ZC) = o;
          }
      }
    });
}

DI void phase_outproj(const Params& P, int wv, int l, char* lds) {
  const u16* W = (const u16*)(P.ws + WS_WOUT) + (size_t)l * D * D;
  const u16* mm = (const u16*)(P.ws + WS_HM);
  u16* y = (u16*)(P.ws + WS_Y);
  const int ntt = (l == DEPTH - 1) ? (ML / 256) : NTT;
  gemm_phase<true>(P, wv, mm, W, ntt * 4, 4, (LAS unsigned char*)lds,
    [&](const f32x4 (&acc)[2][2][4][2], int pm, int pn, int wr, int wc, int fr, int fq) __attribute__((always_inline)) {
      const int row0 = pm * BM + wr * 64 + fr, col0 = pn * BM + wc * 32 + 8 * fq;
      #pragma unroll
      for (int ai = 0; ai < 2; ++ai)
      #pragma unroll
        for (int m = 0; m < 4; ++m) {
          u16* rowp = y + (size_t)(row0 + ai * HALF + m * 16) * D + col0;
          #pragma unroll
          for (int bj = 0; bj < 2; ++bj) {
            const f32x4 v0 = acc[ai][bj][m][0], v1 = acc[ai][bj][m][1];
            uint4 o; o.x = pk2(v0[0], v0[1]); o.y = pk2(v0[2], v0[3]); o.z = pk2(v1[0], v1[1]); o.w = pk2(v1[2], v1[3]);
            *(uint4*)(rowp + bj * HALF) = o;
          }
        }
    });
  if (l + 1 < DEPTH) {
    const int busy = ntt * 4 - 4 * (int)gridDim.x;
    if (busy > 0 && busy < (int)gridDim.x && (int)blockIdx.x >= busy)
      transpose_tiles(P, opaque_tid(wv), lds, l + 1, (int)blockIdx.x - busy, (int)gridDim.x - busy);
    else if (busy <= 0 || busy >= (int)gridDim.x)
      transpose_tiles(P, opaque_tid(wv), lds, l + 1, (int)blockIdx.x, (int)gridDim.x);
  }
}

constexpr int BIAS_OFF = 832 * 128;
struct AttnTask { int b, h, r0, half, lat; };
DI AttnTask attn_decode(int task) {
  AttnTask t; t.lat = (task < 4096) ? 1 : 0; t.r0 = 0; t.half = 0;
  if (t.lat) { t.b = task >> 8; t.h = (task >> 5) & 7; t.r0 = (task & 31) * 2; }
  else { const int t2 = task - 4096; t.b = t2 >> 4; t.h = (t2 >> 1) & 7; t.half = t2 & 1; }
  return t;
}

DI void attn_loop(const Params& P, int wv, int l, int n_attn, char* lds_g, int r_begin, int r_end) {
  LAS char* lds = (LAS char*)lds_g;
  const u16* z = (const u16*)(P.ws + WS_Z);
  u16* mb = (u16*)(P.ws + WS_HM);
  const int tid = opaque_tid(wv);
  const int G = gridDim.x;
  int task = logical_block() + r_begin * G, round = r_begin;
  if (task >= n_attn || r_begin >= r_end) return;

  int lane, fr, fq, w, st_lds, kl0, kl1, tl[4];
  const u16* zl;
  auto lane_consts = [&](int tq) __attribute__((always_inline)) {
    lane = tq & 63; fr = lane & 15; fq = lane >> 4;
    w = __builtin_amdgcn_readfirstlane(tq >> 6);
    const int st_row = tq >> 3, st_c = tq & 7;
    st_lds = st_row * 128 + ((st_c ^ (((st_row >> 1) & 3) << 1) ^ ((st_row >> 3) & 1)) << 4);
    zl = z + (size_t)st_row * ZC + st_c * 8;
    const int ksw = (((fr >> 1) & 3) << 1) ^ (fr >> 3);
    kl0 = fr * 128 + ((fq ^ ksw) << 4);
    kl1 = fr * 128 + (((fq + 4) ^ ksw) << 4);
    const int q4 = fr >> 2, p4 = fr & 3, trow = 4 * fq + q4, tsw = (((trow >> 1) & 3) << 1) ^ (fq >> 1);
    #pragma unroll
    for (int mbk = 0; mbk < 4; ++mbk) tl[mbk] = trow * 128 + (((2 * mbk + (p4 >> 1)) ^ tsw) << 4) + 8 * (p4 & 1);
  };
  lane_consts(tid);
  typedef LAS s16x4* lds_s16x4_p;
  constexpr float LOG2E = 1.4426950408889634f;
  constexpr float SC2 = 0.125f * LOG2E;

  u32x4 rg[13];
  float brg[2];
  auto load_img = [&](const AttnTask& t, int coloff) __attribute__((always_inline)) {
    const size_t ctxbase = (size_t)ML + t.b * NCTX;
    const int rs0 = clampi(t.r0 - 4, 0, 56);
    #pragma unroll
    for (int i = 0; i < 4; ++i) rg[9 + i] = *(const u32x4*)(zl + (ctxbase + i * 64) * ZC + coloff);
    if (t.lat) {
      #pragma unroll
      for (int i = 0; i < 9; ++i) {
        const int gr = min(rs0 + i, 63);
        rg[i] = *(const u32x4*)(zl + ((size_t)t.b * SEQ + gr * 64) * ZC + coloff);
      }
    }
  };
  auto store_img = [&](const AttnTask& t) __attribute__((always_inline)) {
    if (t.lat) {
      #pragma unroll
      for (int i = 0; i < 9; ++i) *(LAS u32x4*)(lds + st_lds + i * 8192) = rg[i];
    }
    #pragma unroll
    for (int i = 0; i < 4; ++i) *(LAS u32x4*)(lds + st_lds + (9 + i) * 8192) = rg[9 + i];
  };
  auto load_bias = [&](const AttnTask& t) __attribute__((always_inline)) {
    if (t.lat) {
      #pragma unroll
      for (int j = 0; j < 2; ++j) {
        const int id = tid + j * 512, ri = id >> 6, ci = (id & 63) - 16;
        brg[j] = (id < 960 && ci >= 0 && ci < 31) ? P.rpb[((size_t)l * 8 + t.h) * 465 + ri * 31 + ci] * LOG2E : 0.f;
      }
    }
  };

  AttnTask cur = attn_decode(task);
  load_img(cur, Z_K + cur.h * 64);
  load_bias(cur);
  if (wv >= 4) __builtin_amdgcn_s_setprio(1);
  for (;;) {
    { int tq = tid; asm volatile("" : "+v"(tq)); lane_consts(tq); }
    store_img(cur);
    if (cur.lat) {
      ((LAS float*)(lds + BIAS_OFF))[tid] = brg[0];
      if (tid < 960 - 512) ((LAS float*)(lds + BIAS_OFF))[tid + 512] = brg[1];
    }
    load_img(cur, Z_V + cur.h * 64);
    const int b = cur.b, h = cur.h;
    const size_t ctxbase = (size_t)ML + b * NCTX;
    const int rs0 = clampi(cur.r0 - 4, 0, 56);
    int r = 0, c0 = 0, rs = 0, rowoff = 0, cb = 0;
    size_t qtok;
    if (cur.lat) {
      r = cur.r0 + (w >> 2); c0 = 16 * (w & 3); rs = clampi(r - 4, 0, 56); rowoff = rs - rs0; cb = clampi(c0 - 8, 0, 32);
      qtok = (size_t)b * SEQ + r * 64 + c0 + fr;
    } else {
      qtok = ctxbase + cur.half * 128 + w * 16 + fr;
    }
    const int wb = (rowoff * 64 + cb) * 128;
    const int pbx = ((cb >> 3) & 1) << 4;
    const bf16x8 qf0 = *(const bf16x8*)(z + qtok * ZC + Z_Q + h * 64 + fq * 8);
    const bf16x8 qf1 = *(const bf16x8*)(z + qtok * ZC + Z_Q + h * 64 + 32 + fq * 8);
    __syncthreads();

    bf16x8 pc[8], pw[8];
    float mc, lc = 0.f, mw = -1e30f, lw = 0.f;
    {
      f32x4 sc[16];
      float mxc = -1e30f;
      bf16x8 fa[4], fb[4];
      #pragma unroll
      for (int u = 0; u < 2; ++u) {
        fa[2 * u]     = *(const LAS bf16x8*)(lds + 73728 + kl0 + u * 2048);
        fa[2 * u + 1] = *(const LAS bf16x8*)(lds + 73728 + kl1 + u * 2048);
      }
      #pragma unroll
      for (int g = 0; g < 8; ++g) {
        if (g + 1 < 8) {
          #pragma unroll
          for (int u = 0; u < 2; ++u) {
            const bf16x8 x0 = *(const LAS bf16x8*)(lds + 73728 + kl0 + (2 * g + 2 + u) * 2048);
            const bf16x8 x1 = *(const LAS bf16x8*)(lds + 73728 + kl1 + (2 * g + 2 + u) * 2048);
            if (g & 1) { fa[2 * u] = x0; fa[2 * u + 1] = x1; } else { fb[2 * u] = x0; fb[2 * u + 1] = x1; }
          }
        }
        __builtin_amdgcn_sched_barrier(0);
        #pragma unroll
        for (int u = 0; u < 2; ++u) {
          const bf16x8 k0 = (g & 1) ? fb[2 * u] : fa[2 * u];
          const bf16x8 k1 = (g & 1) ? fb[2 * u + 1] : fa[2 * u + 1];
          f32x4 a = {0.f, 0.f, 0.f, 0.f};
          a = __builtin_amdgcn_mfma_f32_16x16x32_bf16(k0, qf0, a, 0, 0, 0);
          a = __builtin_amdgcn_mfma_f32_16x16x32_bf16(k1, qf1, a, 0, 0, 0);
          #pragma unroll
          for (int i = 0; i < 4; ++i) mxc = fmaxf(mxc, a[i]);
          sc[2 * g + u] = a;
        }
        __builtin_amdgcn_sched_barrier(0);
      }
      mxc = fmaxf(mxc, __shfl_xor(mxc, 16));
      mxc = fmaxf(mxc, __shfl_xor(mxc, 32));
      mc = mxc * SC2;
      #pragma unroll
      for (int jj = 0; jj < 8; ++jj) {
        float e[8];
        #pragma unroll
        for (int i = 0; i < 4; ++i) { e[i] = fexp2(sc[2 * jj][i] * SC2 - mc); e[4 + i] = fexp2(sc[2 * jj + 1][i] * SC2 - mc); }
        #pragma unroll
        for (int i = 0; i < 8; ++i) lc += e[i];
        u32x4 bu; bu[0] = pk2(e[0], e[1]); bu[1] = pk2(e[2], e[3]); bu[2] = pk2(e[4], e[5]); bu[3] = pk2(e[6], e[7]);
        pc[jj] = __builtin_bit_cast(bf16x8, bu);
      }
    }
    if (cur.lat) {
      const int qc = c0 + fr, cs = clampi(qc - 8, 0, 48);
      bool vm[4];
      int boff[4];
      const int bci = cb - c0 + 15 + 4 * fq - fr + 16;
      #pragma unroll
      for (int i = 0; i < 4; ++i) { const int kc = cb + 4 * fq + i; vm[i] = (kc >= cs) && (kc < cs + 16); boff[i] = bci + i + (vm[i] ? 0 : 16); }
      const LAS float* bl = (const LAS float*)(lds + BIAS_OFF) + (rs - r + 7) * 64;
      const int wk0 = wb + (kl0 ^ pbx), wk1 = wb + (kl1 ^ pbx);
      f32x4 sw[8];
      float mxw = -1e30f;
      bf16x8 fa[4], fb[4];
      float ba[4], bb[4];
      fa[0] = *(const LAS bf16x8*)(lds + wk0); fa[1] = *(const LAS bf16x8*)(lds + wk1);
      fa[2] = *(const LAS bf16x8*)(lds + wk0 + 2048); fa[3] = *(const LAS bf16x8*)(lds + wk1 + 2048);
      #pragma unroll
      for (int i = 0; i < 4; ++i) ba[i] = bl[boff[i]];
      #pragma unroll
      for (int jj = 0; jj < 8; ++jj) {
        if (jj + 1 < 8) {
          const bf16x8 x0 = *(const LAS bf16x8*)(lds + wk0 + (jj + 1) * 8192), x1 = *(const LAS bf16x8*)(lds + wk1 + (jj + 1) * 8192);
          const bf16x8 x2 = *(const LAS bf16x8*)(lds + wk0 + (jj + 1) * 8192 + 2048), x3 = *(const LAS bf16x8*)(lds + wk1 + (jj + 1) * 8192 + 2048);
          if (jj & 1) { fa[0] = x0; fa[1] = x1; fa[2] = x2; fa[3] = x3; } else { fb[0] = x0; fb[1] = x1; fb[2] = x2; fb[3] = x3; }
          #pragma unroll
          for (int i = 0; i < 4; ++i) { const float t = bl[(jj + 1) * 64 + boff[i]]; if (jj & 1) ba[i] = t; else bb[i] = t; }
        }
        __builtin_amdgcn_sched_barrier(0);
        f32x4 a0 = {0.f, 0.f, 0.f, 0.f}, a1 = {0.f, 0.f, 0.f, 0.f};
        a0 = __builtin_amdgcn_mfma_f32_16x16x32_bf16((jj & 1) ? fb[0] : fa[0], qf0, a0, 0, 0, 0);
        a0 = __builtin_amdgcn_mfma_f32_16x16x32_bf16((jj & 1) ? fb[1] : fa[1], qf1, a0, 0, 0, 0);
        a1 = __builtin_amdgcn_mfma_f32_16x16x32_bf16((jj & 1) ? fb[2] : fa[2], qf0, a1, 0, 0, 0);
        a1 = __builtin_amdgcn_mfma_f32_16x16x32_bf16((jj & 1) ? fb[3] : fa[3], qf1, a1, 0, 0, 0);
        f32x4 a;
        #pragma unroll
        for (int i = 0; i < 4; ++i) {
          const float bias = (jj & 1) ? bb[i] : ba[i];
          a[i] = (vm[i] ? a0[i] : a1[i]) * SC2 + bias;
          mxw = fmaxf(mxw, a[i]);
        }
        sw[jj] = a;
        __builtin_amdgcn_sched_barrier(0);
      }
      mxw = fmaxf(mxw, __shfl_xor(mxw, 16));
      mxw = fmaxf(mxw, __shfl_xor(mxw, 32));
      mw = mxw;
      #pragma unroll
      for (int jj = 0; jj < 8; ++jj) {
        float e0[4], e1[4];
        #pragma unroll
        for (int i = 0; i < 4; ++i) {
          const float e = fexp2(sw[jj][i] - mw);
          lw += e;
          e0[i] = vm[i] ? e : 0.f; e1[i] = vm[i] ? 0.f : e;
        }
        u32x4 bu; bu[0] = pk2(e0[0], e0[1]); bu[1] = pk2(e0[2], e0[3]); bu[2] = pk2(e1[0], e1[1]); bu[3] = pk2(e1[2], e1[3]);
        pw[jj] = __builtin_bit_cast(bf16x8, bu);
      }
    } else {
      #pragma unroll
      for (int jj = 0; jj < 8; ++jj) pw[jj] = (bf16x8){0, 0, 0, 0, 0, 0, 0, 0};
    }
    lc += __shfl_xor(lc, 16); lc += __shfl_xor(lc, 32);
    lw += __shfl_xor(lw, 16); lw += __shfl_xor(lw, 32);
    const float mfin = fmaxf(mc, mw);
    const float fc = fexp2(mc - mfin), fw = fexp2(mw - mfin);
    const float inv = __builtin_amdgcn_rcpf(lc * fc + lw * fw);
    const float gc = fc * inv, gw = fw * inv;

    __syncthreads();
    store_img(cur);
    const int ntask = task + G;
    const bool has_next = (ntask < n_attn) && (round + 1 < r_end);
    AttnTask nxt = cur;
    if (has_next) { nxt = attn_decode(ntask); load_img(nxt, Z_K + nxt.h * 64); load_bias(nxt); }
    __syncthreads();

    uint2 gv[4];
    #pragma unroll
    for (int mbk = 0; mbk < 4; ++mbk) gv[mbk] = *(const uint2*)(z + qtok * ZC + Z_NG + h * 64 + 16 * mbk + 4 * fq);
    f32x4 oc[4], ow[4];
    #pragma unroll
    for (int mbk = 0; mbk < 4; ++mbk) { f32x4 zz = {0.f, 0.f, 0.f, 0.f}; oc[mbk] = zz; ow[mbk] = zz; }
    {
      s16x4 r3[3][8];
      #pragma unroll
      for (int p = 0; p < 2; ++p)
      #pragma unroll
        for (int mbk = 0; mbk < 4; ++mbk) {
          r3[p][2 * mbk]     = __builtin_amdgcn_ds_read_tr16_b64_v4i16((lds_s16x4_p)(lds + 73728 + tl[mbk] + p * 4096));
          r3[p][2 * mbk + 1] = __builtin_amdgcn_ds_read_tr16_b64_v4i16((lds_s16x4_p)(lds + 73728 + tl[mbk] + p * 4096 + 2048));
        }
      #pragma unroll
      for (int jj = 0; jj < 8; ++jj) {
        if (jj + 2 < 8) {
          #pragma unroll
          for (int mbk = 0; mbk < 4; ++mbk) {
            r3[(jj + 2) % 3][2 * mbk]     = __builtin_amdgcn_ds_read_tr16_b64_v4i16((lds_s16x4_p)(lds + 73728 + tl[mbk] + (jj + 2) * 4096));
            r3[(jj + 2) % 3][2 * mbk + 1] = __builtin_amdgcn_ds_read_tr16_b64_v4i16((lds_s16x4_p)(lds + 73728 + tl[mbk] + (jj + 2) * 4096 + 2048));
          }
        }
        __builtin_amdgcn_sched_barrier(0);
        #pragma unroll
        for (int mbk = 0; mbk < 4; ++mbk) {
          const bf16x8 av = __builtin_shufflevector(r3[jj % 3][2 * mbk], r3[jj % 3][2 * mbk + 1], 0, 1, 2, 3, 4, 5, 6, 7);
          oc[mbk] = __builtin_amdgcn_mfma_f32_16x16x32_bf16(av, pc[jj], oc[mbk], 0, 0, 0);
        }
        __builtin_amdgcn_sched_barrier(0);
      }
    }
    if (cur.lat) {
      s16x4 r3[3][8];
      const int tw = wb;
      #pragma unroll
      for (int p = 0; p < 2; ++p)
      #pragma unroll
        for (int mbk = 0; mbk < 4; ++mbk) {
          const int ta = tw + (tl[mbk] ^ pbx) + p * 8192;
          r3[p][2 * mbk]     = __builtin_amdgcn_ds_read_tr16_b64_v4i16((lds_s16x4_p)(lds + ta));
          r3[p][2 * mbk + 1] = __builtin_amdgcn_ds_read_tr16_b64_v4i16((lds_s16x4_p)(lds + ta + 2048));
        }
      #pragma unroll
      for (int jj = 0; jj < 8; ++jj) {
        if (jj + 2 < 8) {
          #pragma unroll
          for (int mbk = 0; mbk < 4; ++mbk) {
            const int ta = tw + (tl[mbk] ^ pbx) + (jj + 2) * 8192;
            r3[(jj + 2) % 3][2 * mbk]     = __builtin_amdgcn_ds_read_tr16_b64_v4i16((lds_s16x4_p)(lds + ta));
            r3[(jj + 2) % 3][2 * mbk + 1] = __builtin_amdgcn_ds_read_tr16_b64_v4i16((lds_s16x4_p)(lds + ta + 2048));
          }
        }
        __builtin_amdgcn_sched_barrier(0);
        #pragma unroll
        for (int mbk = 0; mbk < 4; ++mbk) {
          const bf16x8 av = __builtin_shufflevector(r3[jj % 3][2 * mbk], r3[jj % 3][2 * mbk + 1], 0, 1, 2, 3, 4, 5, 6, 7);
          ow[mbk] = __builtin_amdgcn_mfma_f32_16x16x32_bf16(av, pw[jj], ow[mbk], 0, 0, 0);
        }
        __builtin_amdgcn_sched_barrier(0);
      }
    }
    #pragma unroll
    for (int mbk = 0; mbk < 4; ++mbk) {
      const int dh = 16 * mbk + 4 * fq;
      const float g0 = bflo(gv[mbk].x), g1 = bfhi(gv[mbk].x), g2 = bflo(gv[mbk].y), g3 = bfhi(gv[mbk].y);
      const float o0 = oc[mbk][0] * gc + ow[mbk][0] * gw, o1 = oc[mbk][1] * gc + ow[mbk][1] * gw;
      const float o2 = oc[mbk][2] * gc + ow[mbk][2] * gw, o3 = oc[mbk][3] * gc + ow[mbk][3] * gw;
      uint2 ov; ov.x = pk2(o0 * g0, o1 * g1); ov.y = pk2(o2 * g2, o3 * g3);
      *(uint2*)(mb + qtok * D + 256 + h * 64 + dh) = ov;
    }
    __syncthreads();
    if (!has_next) break;
    cur = nxt; task = ntask; ++round;
  }
  __builtin_amdgcn_s_setprio(0);
}

struct ConvTask { int L, t0; size_t tokbase; };
DI ConvTask conv_decode(int task) {
  ConvTask t;
  if (task < 1024) { const int b = task >> 6; t.t0 = (task & 63) * 64; t.L = SEQ; t.tokbase = (size_t)b * SEQ; }
  else { const int t2 = task - 1024; const int b = t2 >> 2; t.t0 = (t2 & 3) * 64; t.L = NCTX; t.tokbase = (size_t)ML + b * NCTX; }
  return t;
}

DI void conv_loop(const Params& P, int wv, int l, int n_conv, int first, char* lds, int max_iters) {
  const u16* z = (const u16*)(P.ws + WS_Z);
  u16* mb = (u16*)(P.ws + WS_HM);
  const int tid = opaque_tid(wv);
  const int G = gridDim.x;
  int task = first, iters = 1;
  if (task >= n_conv) return;
  u16* U = (u16*)lds;
  float* O = (float*)(lds + 49152);

  uint4 pv[6];
  auto load_pq = [&](const ConvTask& t, int tq_) __attribute__((always_inline)) {
    #pragma unroll
    for (int it = 0; it < 6; ++it) {
      const int id = tq_ + it * 512, trow = id >> 5, cgA = id & 31;
      const int tt = t.t0 - 15 + trow;
      const bool ok = (id < 94 * 32) && tt >= 0 && tt < t.L;
      const u16* zr = z + (t.tokbase + (ok ? tt : t.t0)) * ZC;
      pv[it] = *(const uint4*)(zr + Z_CFU + cgA * 8);
    }
  };
  ConvTask cur = conv_decode(task);
  load_pq(cur, tid);

  for (;;) {
    const int L = cur.L, t0 = cur.t0; const size_t tokbase = cur.tokbase;
    int lq = l, tq = tid;
    asm volatile("" : "+s"(lq), "+v"(tq));
    const int c = tq & 255, run = tq >> 8;
    const int cg8 = tq & 31, srun = tq >> 5;
    const int lane = tq & 63, w = tq >> 6;
    #pragma unroll
    for (int it = 0; it < 6; ++it) {
      const int id = tq + it * 512, trow = id >> 5, cgA = id & 31;
      const int tt = t0 - 15 + trow;
      const bool ok = tt >= 0 && tt < L;
      if (id < 94 * 32) {
        uint4 o = pv[it];
        if (!ok) o = make_uint4(0u, 0u, 0u, 0u);
        *(uint4*)(U + trow * 256 + cgA * 8) = o;
      }
    }
    {
    uint4 hv[6], bv[4];
    #pragma unroll
    for (int jj = 0; jj < 6; ++jj) {
      const int tt = t0 + srun * 4 - 1 + jj;
      const bool ok = tt >= 0 && tt < L;
      const u16* zr = z + (tokbase + (ok ? tt : t0)) * ZC;
      hv[jj] = *(const uint4*)(zr + Z_SCV + cg8 * 8);
    }
    #pragma unroll
    for (int i = 0; i < 4; ++i) {
      const u16* zr = z + (tokbase + t0 + srun * 4 + i) * ZC;
      bv[i] = *(const uint4*)(zr + Z_SCG + cg8 * 8);
    }
      const float* wsc = P.conv_sc + (size_t)lq * 3 * 256 + cg8 * 8;
      float w0[8], w1[8], w2[8];
      #pragma unroll
      for (int e = 0; e < 8; ++e) { w0[e] = wsc[e]; w1[e] = wsc[256 + e]; w2[e] = wsc[512 + e]; }
      float v[6][8];
      #pragma unroll
      for (int jj = 0; jj < 6; ++jj) {
        const int tt = t0 + srun * 4 - 1 + jj;
        const bool ok = tt >= 0 && tt < L;
        float hf[8]; unpack8(hv[jj], hf);
        #pragma unroll
        for (int e = 0; e < 8; ++e) v[jj][e] = ok ? hf[e] : 0.f;
      }
      #pragma unroll
      for (int i = 0; i < 4; ++i) {
        const size_t tok = tokbase + t0 + srun * 4 + i;
        float bf[8], of[8]; unpack8(bv[i], bf);
        #pragma unroll
        for (int e = 0; e < 8; ++e)
          of[e] = bf[e] * (w0[e] * v[i][e] + w1[e] * v[i + 1][e] + w2[e] * v[i + 2][e]);
        uint4 ov; ov.x = pk2(of[0], of[1]); ov.y = pk2(of[2], of[3]); ov.z = pk2(of[4], of[5]); ov.w = pk2(of[6], of[7]);
        *(uint4*)(mb + tok * D + cg8 * 8) = ov;
      }
    }

    __syncthreads();

    const int ntask = task + G;
    const bool has_next = (ntask < n_conv) && (iters < max_iters);
    ConvTask nxt = cur;
    if (has_next) { nxt = conv_decode(ntask); load_pq(nxt, tq); }

    {
      const float* wcf = P.conv_cf + (size_t)lq * 31 * 256 + c;
      float wk[31];
      #pragma unroll
      for (int k = 0; k < 31; ++k) wk[k] = wcf[k * 256];
      f32x2 W2[32];
      #pragma unroll
      for (int k = 0; k < 32; ++k) { W2[k][0] = (k < 31) ? wk[k] : 0.f; W2[k][1] = (k > 0) ? wk[k - 1] : 0.f; }
      const float bias = P.conv_cf_b[lq * 256 + c];
      #pragma unroll 1
      for (int ob = 0; ob < 4; ++ob) {
        const int r0 = run * 32 + ob * 8;
        const u16* up = U + r0 * 256 + c;
        f32x2 acc2[4];
        #pragma unroll
        for (int p = 0; p < 4; ++p) { acc2[p][0] = bias; acc2[p][1] = bias; }
        unsigned short raw[38];
        #pragma unroll
        for (int jj = 0; jj < 38; ++jj) raw[jj] = up[jj * 256];
        __builtin_amdgcn_sched_barrier(0);
        #pragma unroll
        for (int jj = 0; jj < 38; ++jj) {
          const float val = __uint_as_float(((unsigned)raw[jj]) << 16);
          f32x2 v2; v2[0] = val; v2[1] = val;
          #pragma unroll
          for (int p = 0; p < 4; ++p) {
            if (jj - 2 * p >= 0 && jj - 2 * p <= 31) acc2[p] = W2[jj - 2 * p] * v2 + acc2[p];
          }
        }
        #pragma unroll
        for (int p = 0; p < 4; ++p) { O[(r0 + 2 * p) * 256 + c] = acc2[p][0]; O[(r0 + 2 * p + 1) * 256 + c] = acc2[p][1]; }
      }
    }
    uint2 zg[8];
    #pragma unroll
    for (int i = 0; i < 8; ++i) zg[i] = *(const uint2*)(z + (tokbase + t0 + w * 8 + i) * ZC + Z_CFG + lane * 4);
    __syncthreads();

    {
      const float4 lg = *(const float4*)(P.ln_cf_g + lq * 256 + lane * 4);
      const float4 lb = *(const float4*)(P.ln_cf_b + lq * 256 + lane * 4);
      float4 xva[8];
      #pragma unroll
      for (int i = 0; i < 8; ++i) xva[i] = *(const float4*)(O + (w * 8 + i) * 256 + lane * 4);
      __builtin_amdgcn_sched_barrier(0);
      #pragma unroll
      for (int i = 0; i < 8; ++i) {
        const int ti = w * 8 + i;
        const float4 xv = xva[i];
        const float s = wave_sum(xv.x + xv.y + xv.z + xv.w);
        const float mu = s * (1.f / 256.f);
        float d0 = xv.x - mu, d1 = xv.y - mu, d2 = xv.z - mu, d3 = xv.w - mu;
        const float q = wave_sum(d0 * d0 + d1 * d1 + d2 * d2 + d3 * d3);
        const float rstd = rsqrtf(q * (1.f / 256.f) + 1e-5f);
        const size_t tok = tokbase + t0 + ti;
        float y0 = silu_f(d0 * rstd * lg.x + lb.x) * bflo(zg[i].x);
        float y1 = silu_f(d1 * rstd * lg.y + lb.y) * bfhi(zg[i].x);
        float y2 = silu_f(d2 * rstd * lg.z + lb.z) * bflo(zg[i].y);
        float y3 = silu_f(d3 * rstd * lg.w + lb.w) * bfhi(zg[i].y);
        uint2 ov; ov.x = pk2(y0, y1); ov.y = pk2(y2, y3);
        *(uint2*)(mb + tok * D + 768 + lane * 4) = ov;
      }
    }
    if (!has_next) break;
    cur = nxt; task = ntask; ++iters;
  }
  __syncthreads();
}

DI void phase_mixer(const Params& P, int wv, int l, char* lds, int which = 3) {
  const bool last = (l == DEPTH - 1);
  const int n_attn = last ? 4096 : 4352;
  const int n_conv = last ? 1024 : 1088;
  const int G = gridDim.x;
  const int nr = (n_attn + G - 1) / G;
  const int L = logical_block();
  int l2 = l;
  asm volatile("" : "+s"(l2));
  if (which & 1) attn_loop(P, wv, l2, n_attn, lds, 0, nr);
  asm volatile("" : "+s"(l2));
  if (which & 2) conv_loop(P, wv, l2, n_conv, L, lds, 1000);
}

#define XB_TMO      128
#define XB_XCNT(j)  (256  + 64 * (j))
#define XB_XSUB(j)  (1280 + 64 * (j))
#define XB_XGEN(j)  (2304 + 64 * (j))
#define XB_TOP      3328
#define XB_TOPGEN   3392
#define XCD_BAR_WORDS 3456
#define XB_SPIN_CAP (1u << 18)
DI unsigned xb_ld(unsigned* p)              { return __hip_atomic_load(p, __ATOMIC_RELAXED, __HIP_MEMORY_SCOPE_AGENT); }
DI unsigned xb_add(unsigned* p, unsigned v) { return __hip_atomic_fetch_add(p, v, __ATOMIC_RELAXED, __HIP_MEMORY_SCOPE_AGENT); }
DI unsigned xb_xcc_id() { return (unsigned)__builtin_amdgcn_s_getreg((3 << 11) | 20) & 0xFu; }
#define XB_SPIN(cond, bar) do { unsigned _sp = 0; while (cond) { __builtin_amdgcn_s_sleep(1); \
    if ((++_sp & 255u) == 0u) { if (xb_ld(&(bar)[XB_TMO])) break; if (_sp > XB_SPIN_CAP) { atomicAdd(&(bar)[XB_TMO], 1u); break; } } } } while (0)
struct XcdBarrier { unsigned* bar; unsigned x; volatile LAS unsigned* st; };
DI XcdBarrier xcd_barrier_post(unsigned* bar, volatile LAS unsigned* st) {
  XcdBarrier b; b.bar = bar; b.x = xb_xcc_id(); b.st = st;
  if (threadIdx.x == 0) (void)xb_add(&bar[XB_XCNT(b.x)], 1u);
  return b;
}
DI void xcd_barrier_complete(unsigned* bar, unsigned x, unsigned& nloc, unsigned& nx) {
  const unsigned G = gridDim.x * gridDim.y * gridDim.z;
  unsigned sum, cnt, mine, sp = 0u;
  for (;;) {
    sum = 0u; cnt = 0u; mine = 0u;
    #pragma unroll
    for (unsigned j = 0; j < 16; ++j) { const unsigned c = xb_ld(&bar[XB_XCNT(j)]); sum += c; cnt += (c > 0u) ? 1u : 0u; mine = (j == x) ? c : mine; }
    if (sum == G) break;
    __builtin_amdgcn_s_sleep(1);
    if ((++sp & 255u) == 0u) { if (xb_ld(&bar[XB_TMO])) break; if (sp > XB_SPIN_CAP) { atomicAdd(&bar[XB_TMO], 1u); break; } }
  }
  nloc = mine > 0u ? mine : 1u; nx = cnt > 0u ? cnt : 1u;
}
DI void xcd_barrier(const XcdBarrier& b) {
  asm volatile("s_waitcnt vmcnt(0)" ::: "memory");
  __syncthreads();
  if (threadIdx.x == 0) {
    unsigned* bar = b.bar;
    __builtin_amdgcn_s_waitcnt(0);
    unsigned nloc = b.st[0], nx = b.st[1];
    if (nloc == 0u) { xcd_barrier_complete(bar, b.x, nloc, nx); b.st[0] = nloc; b.st[1] = nx; }
    const unsigned old = xb_add(&bar[XB_XSUB(b.x)], 1u);
    const unsigned gen = old / nloc;
    if (old + 1u == (gen + 1u) * nloc) {
      __builtin_amdgcn_fence(__ATOMIC_RELEASE, "agent");
      asm volatile("s_waitcnt vmcnt(0)" ::: "memory");
      const unsigned og = xb_add(&bar[XB_TOP], 1u);
      const unsigned tg = og / nx;
      if (og + 1u == (tg + 1u) * nx) xb_add(&bar[XB_TOPGEN], 1u);
      else XB_SPIN(xb_ld(&bar[XB_TOPGEN]) == tg, bar);
      __builtin_amdgcn_fence(__ATOMIC_ACQUIRE, "agent");
      xb_add(&bar[XB_XGEN(b.x)], 1u);
      asm volatile("s_waitcnt vmcnt(0)" ::: "memory");
    } else {
      XB_SPIN(xb_ld(&bar[XB_XGEN(b.x)]) == gen, bar);
      __builtin_amdgcn_fence(__ATOMIC_ACQUIRE, "agent");
      asm volatile("s_waitcnt vmcnt(0)" ::: "memory");
    }
  }
  __syncthreads();
}

constexpr int NPHASE = 18;
template <bool COOP>
__global__ void __launch_bounds__(512) mk_kernel(Params P, int ph_lo, int ph_hi) {
  extern __shared__ __attribute__((aligned(16))) char lds[];
  const int wv = __builtin_amdgcn_readfirstlane((int)(threadIdx.x >> 6));
  XcdBarrier xb;
  if (COOP) {
    volatile LAS unsigned* st = (volatile LAS unsigned*)((LAS char*)lds + LDS_WORK);
    if (threadIdx.x == 0) { st[0] = 0u; st[1] = 0u; }
    __syncthreads();
    xb = xcd_barrier_post((unsigned*)(P.ws + WS_BAR), st);
  }
  for (int ph = ph_lo; ph < ph_hi; ++ph) {
    if (ph == 0) phase0(P, wv, lds);
    else if (ph == NPHASE - 1) phase_resnorm(P, wv, DEPTH);
    else {
      const int l = (ph - 1) >> 2, s = (ph - 1) & 3;
      if (s == 0) { phase_resnorm(P, wv, l); }
      else if (s == 1) { phase_inproj(P, wv, l, lds); if (PROBE == 2) { cg::this_grid().sync(); phase_inproj(P, wv, l, lds); } }
      else if (s == 2) { phase_mixer(P, wv, l, lds); if (PROBE == 4) { cg::this_grid().sync(); phase_mixer(P, wv, l, lds, 1); } if (PROBE == 5) { cg::this_grid().sync(); phase_mixer(P, wv, l, lds, 2); } }
      else { phase_outproj(P, wv, l, lds); if (PROBE == 6) { cg::this_grid().sync(); phase_outproj(P, wv, l, lds); } }
    }
    if (COOP) { if (ph + 1 < ph_hi) {
      if (ph_hi > NPHASE) cg::this_grid().sync(); else xcd_barrier(xb);
    } }
  }
}

extern "C" void kernel_launch(void* const* d_in, const int* in_sizes, int n_in, void* d_out, int out_size,
                              void* d_ws, size_t ws_size, hipStream_t stream) {
  static int grid = 0;
  if (grid == 0) {
    if (n_in != 16 || out_size != ML * D || ws_size < WS_END) {
      fprintf(stderr, "kernel_launch: unexpected shapes n_in %d out %d ws %zu (need %zu)\n", n_in, out_size, ws_size, (size_t)WS_END);
      grid = -1; return;
    }
    int dev = 0, cus = 0, per_cu = 0;
    hipGetDevice(&dev);
    hipDeviceGetAttribute(&cus, hipDeviceAttributeMultiprocessorCount, dev);
    const void* fn = MK_COOP ? (const void*)mk_kernel<true> : (const void*)mk_kernel<false>;
    if (hipFuncSetAttribute(fn, hipFuncAttributeMaxDynamicSharedMemorySize, LDS_BYTES) != hipSuccess) {
      fprintf(stderr, "kernel_launch: hipFuncSetAttribute failed\n"); grid = -1; return;
    }
    if (hipOccupancyMaxActiveBlocksPerMultiprocessor(&per_cu, fn, 512, LDS_BYTES) != hipSuccess || per_cu < 1) {
      fprintf(stderr, "kernel_launch: occupancy query gave %d\n", per_cu); per_cu = 1;
    }
    (void)hipGetLastError();
    grid = cus * 1;
  }
  if (grid < 0) return;
  Params p{};
  p.x = (const float*)d_in[0]; p.c = (const float*)d_in[1]; p.ctx = (const float*)d_in[2]; p.c_ctx = (const float*)d_in[3];
  p.norm_g = (const float*)d_in[4]; p.w_ada = (const float*)d_in[5]; p.b_ada = (const float*)d_in[6]; p.w_in = (const float*)d_in[7];
  p.conv_sc = (const float*)d_in[8]; p.rpb = (const float*)d_in[9]; p.conv_cf = (const float*)d_in[10]; p.conv_cf_b = (const float*)d_in[11];
  p.ln_cf_g = (const float*)d_in[12]; p.ln_cf_b = (const float*)d_in[13]; p.w_out = (const float*)d_in[14]; p.final_g = (const float*)d_in[15];
  p.out = (float*)d_out; p.ws = (unsigned char*)d_ws;
  hipMemsetAsync((char*)d_ws + WS_MOD, 0, MOD_BYTES + XCD_BAR_WORDS * 4, stream);
#if MK_COOP
  int lo = 0, hi = NPHASE;
  void* args[] = {&p, &lo, &hi};
  hipError_t e = hipLaunchCooperativeKernel((const void*)mk_kernel<true>, dim3(grid), dim3(512), args, LDS_BYTES, stream);
  if (e != hipSuccess) fprintf(stderr, "cooperative launch failed: %s (grid %d)\n", hipGetErrorString(e), grid);
#else
  for (int ph = 0; ph < NPHASE; ++ph)
    hipLaunchKernelGGL(mk_kernel<false>, dim3(grid), dim3(512), LDS_BYTES, stream, p, ph, ph + 1);
#endif
}
```

```cpp
#include <hip/hip_runtime.h>
#include <hip/hip_cooperative_groups.h>
#include <cstdio>
namespace cg = cooperative_groups;

#ifndef PROBE
#define PROBE 0
#endif
#ifndef MK_COOP
#define MK_COOP 1
#endif

typedef unsigned short u16;
using bf16x8 = __attribute__((ext_vector_type(8))) short;
using s16x4  = __attribute__((ext_vector_type(4))) short;
using f32x4  = __attribute__((ext_vector_type(4))) float;
using u32x4  = __attribute__((ext_vector_type(4))) unsigned;
using f32x2  = __attribute__((ext_vector_type(2))) float;
using u32x2  = __attribute__((ext_vector_type(2))) unsigned;
typedef __attribute__((ext_vector_type(2))) __bf16 bf2_t;
#define DI __device__ __forceinline__

constexpr int D = 1024, NB = 16, SEQ = 4096, NCTX = 256, DP = 3840, DEPTH = 4;
constexpr int ZC = 3072, Z_SCV = 0, Z_SCG = 256, Z_Q = 512, Z_K = 1024, Z_V = 1536, Z_NG = 2048, Z_CFU = 2560, Z_CFG = 2816;
constexpr int ML = NB * SEQ;
constexpr int MC = NB * NCTX;
constexpr int MT = ML + MC;
constexpr int NTT = MT / 256;
constexpr int LDS_WORK = 131072;
constexpr int LDS_BYTES = LDS_WORK + 16;

constexpr size_t WS_WIN  = 0;
constexpr size_t WS_WOUT = WS_WIN + (size_t)DEPTH * DP * D * 2;
constexpr size_t WS_MOD  = WS_WOUT + (size_t)DEPTH * D * D * 2;
constexpr size_t MOD_BYTES = (size_t)DEPTH * 17 * 3072 * 4;
constexpr size_t WS_BAR  = WS_MOD + MOD_BYTES;
constexpr size_t WS_CTX  = WS_MOD + 1048576;
constexpr size_t WS_HM   = WS_CTX + (size_t)MC * D * 4;
constexpr size_t WS_Z    = WS_HM + (size_t)MT * D * 2;
constexpr size_t WS_Y    = WS_Z + (size_t)MT * DP * 2;
constexpr size_t WS_END  = WS_Y + (size_t)MT * D * 2;

struct Params {
  const float *x, *c, *ctx, *c_ctx, *norm_g, *w_ada, *b_ada, *w_in, *conv_sc, *rpb, *conv_cf, *conv_cf_b, *ln_cf_g, *ln_cf_b, *w_out, *final_g;
  float* out;
  unsigned char* ws;
};

DI float fexp2(float v) { return __builtin_amdgcn_exp2f(v); }
DI float sigmoid_f(float v) { return __builtin_amdgcn_rcpf(1.f + fexp2(-1.4426950408889634f * v)); }
DI float silu_f(float v) { return v * sigmoid_f(v); }
DI unsigned pk2(float a, float b) { bf2_t v; v[0] = (__bf16)a; v[1] = (__bf16)b; return __builtin_bit_cast(unsigned, v); }
DI float bflo(unsigned w) { return __uint_as_float(w << 16); }
DI float bfhi(unsigned w) { return __uint_as_float(w & 0xffff0000u); }
DI void unpack8(const uint4& v, float* f) {
  f[0] = bflo(v.x); f[1] = bfhi(v.x); f[2] = bflo(v.y); f[3] = bfhi(v.y);
  f[4] = bflo(v.z); f[5] = bfhi(v.z); f[6] = bflo(v.w); f[7] = bfhi(v.w);
}
DI int opaque_tid(int wv) {
  unsigned m = ~0u;
  asm volatile("" : "+s"(m));
  int t = wv * 64 + (int)__builtin_amdgcn_mbcnt_hi(m, __builtin_amdgcn_mbcnt_lo(m, 0u));
  asm volatile("" : "+v"(t)); return t;
}
DI void st16_wt(void* p, const uint4& v) {
  u32x4 d; d[0] = v.x; d[1] = v.y; d[2] = v.z; d[3] = v.w;
  asm volatile("global_store_dwordx4 %0, %1, off sc1" :: "v"(p), "v"(d) : "memory");
}
template <int CTRL, int RMASK> DI float dpp0(float x) { return __int_as_float(__builtin_amdgcn_update_dpp(0, __float_as_int(x), CTRL, RMASK, 0xf, false)); }
DI float wave_sum(float x) {
  x += dpp0<0xB1, 0xf>(x);
  x += dpp0<0x4E, 0xf>(x);
  x += dpp0<0x124, 0xf>(x);
  x += dpp0<0x128, 0xf>(x);
  x += dpp0<0x142, 0xa>(x);
  x += dpp0<0x143, 0xc>(x);
  return __int_as_float(__builtin_amdgcn_readlane(__float_as_int(x), 63));
}
DI void st16_nt(void* p, const uint4& v) {
  u32x4 d; d[0] = v.x; d[1] = v.y; d[2] = v.z; d[3] = v.w;
  __builtin_nontemporal_store(d, (u32x4*)p);
}
DI int clampi(int v, int lo, int hi) { return v < lo ? lo : (v > hi ? hi : v); }

#define LAS __attribute__((address_space(3)))
constexpr int BM = 256, BK = 64, HALF = 128, HTB = HALF * BK * 2;
DI int lds_byte(int r, int c) { const int st = (r >> 4) * 2 + (c >> 5), rr = r & 15, cc = c & 31, ob = rr * 64 + cc * 2; return st * 1024 + (ob ^ (((ob >> 9) & 1) << 5)); }
DI void stage_rc(int b, int& R, int& C) { const int st = b / 1024, sb = b % 1024, swz = sb ^ (((sb >> 9) & 1) << 5); R = (st >> 1) * 16 + swz / 64; C = (st & 1) * 32 + (swz % 64) / 2; }
DI int perm32(int rho) { const int n = rho >> 4, i = rho & 15; return 8 * (i >> 2) + 4 * n + (i & 3); }

DI int win_src_col(int n) {
  const int pn = n >> 8, r = n & 255, half = r >> 7, q = r & 127;
  if (pn == 0 || pn == 1) return (half ? 512 : 0) + pn * 128 + q;
  if (pn == 2 || pn == 3) return (half ? 768 : 256) + (pn - 2) * 128 + q;
  if (pn == 12 || pn == 13) return (half ? 3328 : 3072) + (pn - 12) * 128 + q;
  return n;
}

DI int logical_block() {
  int g = gridDim.x;
  if ((g & 7) == 0) return (blockIdx.x & 7) * (g >> 3) + (blockIdx.x >> 3);
  return blockIdx.x;
}

template <bool PERM, class Epi>
DI void gemm_phase(const Params& P, int wv, const u16* __restrict__ Aact, const u16* __restrict__ Wt, int ntiles, int nct, LAS unsigned char* lds, Epi&& E) {
  constexpr int K = 1024, nt = K / BK;
  const int tid = opaque_tid(wv), wid = tid >> 6, lane = tid & 63, wr = wid >> 2, wc = wid & 3, fr = lane & 15, fq = lane >> 4;
  const int G = gridDim.x;
  unsigned voffA[2], voffB[2];
  #pragma unroll
  for (int i = 0; i < 2; ++i) { int R, C; stage_rc(tid * 16 + i * 8192, R, C); const int Rb = PERM ? ((R & ~31) + perm32(R & 31)) : R;
    voffA[i] = (unsigned)(R * K + C) * 2u; voffB[i] = (unsigned)(Rb * K + C) * 2u; }
  const size_t kstep = (size_t)(BK * 2), hstep = (size_t)HALF * K * 2, tstep = 2 * hstep;
  const unsigned ldsw = (unsigned)wid * 1024u;
  const int aoff = lds_byte(wr * 64 + fr, fq * 8), boff = lds_byte(wc * 32 + fr, fq * 8);
  #define G_SA(b, h) (((b) * 2 + (h)) * HTB)
  #define G_SB(b, h) ((4 + (b) * 2 + (h)) * HTB)
  #define G_STAGE(bufoff, gbase, voff) do { _Pragma("unroll") for (int _i = 0; _i < 2; ++_i) \
      __builtin_amdgcn_global_load_lds((const unsigned*)((const char*)(gbase) + (voff)[_i]), (LAS unsigned*)(lds + (bufoff) + ldsw + _i * 8192), 16, 0, 0); } while (0)
  #define G_LDA(dst, b, h) do { _Pragma("unroll") for (int m = 0; m < 4; ++m) _Pragma("unroll") for (int k = 0; k < 2; ++k) dst[m][k] = *(const LAS bf16x8*)(lds + G_SA(b, h) + aoff + m * 2048 + k * 1024); } while (0)
  #define G_LDB(dst, b, h) do { _Pragma("unroll") for (int n = 0; n < 2; ++n) _Pragma("unroll") for (int k = 0; k < 2; ++k) dst[n][k] = *(const LAS bf16x8*)(lds + G_SB(b, h) + boff + n * 2048 + k * 1024); } while (0)
  #define G_MMA(ai, bj, At, Bt) do { __builtin_amdgcn_s_setprio(1); _Pragma("unroll") for (int m = 0; m < 4; ++m) _Pragma("unroll") for (int n = 0; n < 2; ++n) _Pragma("unroll") for (int k = 0; k < 2; ++k) \
      acc[ai][bj][m][n] = __builtin_amdgcn_mfma_f32_16x16x32_bf16(Bt[n][k], At[m][k], acc[ai][bj][m][n], 0, 0, 0); __builtin_amdgcn_s_setprio(0); } while (0)
  #define G_WAIT_V(n) asm volatile("s_waitcnt vmcnt(" #n ")" ::: "memory")
  #define G_WAIT_L(n) asm volatile("s_waitcnt lgkmcnt(" #n ")" ::: "memory")
  #define G_BAR __builtin_amdgcn_s_barrier()
  #define G_SCHED __builtin_amdgcn_sched_barrier(0)
  const int ntm = ntiles / nct;
  auto unit = [&](int i, int& pm, int& pn) __attribute__((always_inline)) -> bool {
    const int Lg = i * G + blockIdx.x;
    if (Lg >= ntiles) return false;
    int wg = Lg;
    { const int q = ntiles >> 3, r = ntiles & 7, xcd = wg & 7, off = wg >> 3; wg = (xcd < r ? xcd * (q + 1) : r * (q + 1) + (xcd - r) * q) + off; }
    const int nig = 8 * nct, gid = wg / nig, fm = gid * 8, gsz = (ntm - fm) < 8 ? (ntm - fm) : 8;
    const int rem = wg - gid * nig;
    pm = fm + rem % gsz; pn = rem / gsz; return true;
  };
  int ui = 0, cpm, cpn, npm = 0, npn = 0;
  if (!unit(0, cpm, cpn)) return;
  f32x4 acc[2][2][4][2];
  #pragma unroll
  for (int a = 0; a < 2; ++a)
  #pragma unroll
    for (int b = 0; b < 2; ++b)
  #pragma unroll
      for (int m = 0; m < 4; ++m)
  #pragma unroll
        for (int n = 0; n < 2; ++n) acc[a][b][m][n] = (f32x4){0.f, 0.f, 0.f, 0.f};
  bf16x8 At[4][2], B0[2][2], B1[2][2];
  const char* cA = (const char*)Aact + (size_t)cpm * tstep; const char* cB = (const char*)Wt + (size_t)cpn * tstep;
  G_WAIT_V(0);
  G_STAGE(G_SB(0, 0), cB, voffB); G_STAGE(G_SA(0, 0), cA, voffA); G_STAGE(G_SB(0, 1), cB + hstep, voffB); G_STAGE(G_SA(0, 1), cA + hstep, voffA);
  if (wr == 1) G_BAR;
  G_WAIT_V(4); G_BAR;
  G_STAGE(G_SB(1, 0), cB + kstep, voffB); G_STAGE(G_SA(1, 0), cA + kstep, voffA); G_STAGE(G_SB(1, 1), cB + hstep + kstep, voffB);
  G_WAIT_V(6); G_BAR;
  for (;;) {
    bool has_next;
    has_next = unit(ui + 1, npm, npn);
    const char* nA = has_next ? (const char*)Aact + (size_t)npm * tstep : cA; const char* nB = has_next ? (const char*)Wt + (size_t)npn * tstep : cB;
    for (int t = 0; t < nt; t += 2) {
      const bool last = (t == nt - 2);
      const char* a1 = cA + (size_t)(t + 1) * kstep;
      const char* a2 = last ? nA : cA + (size_t)(t + 2) * kstep; const char* b2 = last ? nB : cB + (size_t)(t + 2) * kstep;
      const char* a3 = a2 + kstep; const char* b3 = b2 + kstep;
      G_LDB(B0, 0, 0); G_SCHED; G_LDA(At, 0, 0); G_STAGE(G_SA(1, 1), a1 + hstep, voffA);
      G_WAIT_L(8); G_BAR; G_WAIT_L(0); G_MMA(0, 0, At, B0); G_BAR; G_SCHED;
      G_LDB(B1, 0, 1); G_STAGE(G_SB(0, 0), b2, voffB);
      G_BAR; G_WAIT_L(0); G_MMA(0, 1, At, B1); G_BAR;
      G_LDA(At, 0, 1); G_STAGE(G_SA(0, 0), a2, voffA);
      G_BAR; G_WAIT_L(0); G_MMA(1, 0, At, B0); G_BAR; G_SCHED;
      G_STAGE(G_SB(0, 1), b2 + hstep, voffB);
      G_WAIT_V(6); G_BAR; G_MMA(1, 1, At, B1); G_BAR;
      G_LDB(B0, 1, 0); G_SCHED; G_LDA(At, 1, 0); G_STAGE(G_SA(0, 1), a2 + hstep, voffA);
      G_WAIT_L(8); G_BAR; G_WAIT_L(0); G_MMA(0, 0, At, B0); G_BAR; G_SCHED;
      G_LDB(B1, 1, 1); G_STAGE(G_SB(1, 0), b3, voffB);
      G_BAR; G_WAIT_L(0); G_MMA(0, 1, At, B1); G_BAR;
      G_LDA(At, 1, 1); G_STAGE(G_SA(1, 0), a3, voffA);
      G_BAR; G_WAIT_L(0); G_MMA(1, 0, At, B0); G_BAR; G_SCHED;
      G_STAGE(G_SB(1, 1), b3 + hstep, voffB);
      G_WAIT_V(6); G_BAR; G_MMA(1, 1, At, B1); G_BAR;
    }
    E(acc, cpm, cpn, wr, wc, fr, fq);
    if (!has_next) break;
    #pragma unroll
    for (int a = 0; a < 2; ++a)
    #pragma unroll
      for (int b = 0; b < 2; ++b)
    #pragma unroll
        for (int m = 0; m < 4; ++m)
    #pragma unroll
          for (int n = 0; n < 2; ++n) acc[a][b][m][n] = (f32x4){0.f, 0.f, 0.f, 0.f};
    cpm = npm; cpn = npn; cA = nA; cB = nB; ++ui;
  }
  G_WAIT_V(0);
  if (wr == 0) G_BAR;
  G_BAR;
  #undef G_SA
  #undef G_SB
  #undef G_STAGE
  #undef G_LDA
  #undef G_LDB
  #undef G_MMA
  #undef G_WAIT_V
  #undef G_WAIT_L
  #undef G_BAR
  #undef G_SCHED
}

DI void transpose_tiles(const Params& P, int tid, char* lds, int l, int first, int stride) {
  u16* winT = (u16*)(P.ws + WS_WIN) + (size_t)l * DP * D;
  u16* woutT = (u16*)(P.ws + WS_WOUT) + (size_t)l * D * D;
  float* tile = (float*)lds;
  for (int t2 = first; t2 < 960 + 256; t2 += stride) {
    const float* src; u16* dst; int N, kt, ntile, n_src;
    if (t2 < 960) { kt = t2 / 60; ntile = t2 % 60; N = DP; src = P.w_in + (size_t)l * D * DP; dst = winT; n_src = win_src_col(ntile * 64); }
    else { const int r2 = t2 - 960; kt = r2 >> 4; ntile = r2 & 15; N = D; src = P.w_out + (size_t)l * D * D; dst = woutT; n_src = ntile * 64; }
    const int k0 = kt * 64, n0 = ntile * 64;
    {
      const int r = tid >> 4, c4 = tid & 15;
      #pragma unroll
      for (int hh = 0; hh < 2; ++hh) {
        float4 v = *(const float4*)(src + (size_t)(k0 + r + hh * 32) * N + n_src + c4 * 4);
        float* tp = tile + (r + hh * 32) * 65 + c4 * 4;
        tp[0] = v.x; tp[1] = v.y; tp[2] = v.z; tp[3] = v.w;
      }
    }
    __syncthreads();
    {
      const int n = tid >> 3, kc = tid & 7;
      float f[8];
      #pragma unroll
      for (int e = 0; e < 8; ++e) f[e] = tile[(kc * 8 + e) * 65 + n];
      uint4 o; o.x = pk2(f[0], f[1]); o.y = pk2(f[2], f[3]); o.z = pk2(f[4], f[5]); o.w = pk2(f[6], f[7]);
      *(uint4*)(dst + (size_t)(n0 + n) * D + k0 + kc * 8) = o;
    }
    __syncthreads();
  }
}

DI void phase0(const Params& P, int wv, char* lds) {
  const int tid = opaque_tid(wv);
  float* mod = (float*)(P.ws + WS_MOD);
  constexpr int NG = 192;
  for (int task = blockIdx.x; task < NG; task += gridDim.x) {
    const int l = task / 48, rem = task % 48, nc = rem >> 3, ks = rem & 7;
    float* s = (float*)lds;
    for (int id = tid; id < 17 * 128; id += 512) {
      int r = id >> 7, kk = id & 127;
      float v = (r < 16) ? P.c[r * D + ks * 128 + kk] : P.c_ctx[ks * 128 + kk];
      s[id] = silu_f(v);
    }
    __syncthreads();
    const int n = nc * 512 + tid;
    float acc[17];
    #pragma unroll
    for (int r = 0; r < 17; ++r) acc[r] = 0.f;
    const float* wp = P.w_ada + ((size_t)l * D + ks * 128) * 3072 + n;
    for (int k4 = 0; k4 < 32; ++k4) {
      float w0 = wp[(size_t)(k4 * 4 + 0) * 3072], w1 = wp[(size_t)(k4 * 4 + 1) * 3072];
      float w2 = wp[(size_t)(k4 * 4 + 2) * 3072], w3 = wp[(size_t)(k4 * 4 + 3) * 3072];
      #pragma unroll
      for (int r = 0; r < 17; ++r) {
        float4 sv = *(const float4*)(s + r * 128 + k4 * 4);
        acc[r] += sv.x * w0 + sv.y * w1 + sv.z * w2 + sv.w * w3;
      }
    }
    const float bias = (ks == 0) ? P.b_ada[l * 3072 + n] : 0.f;
    #pragma unroll
    for (int r = 0; r < 17; ++r) atomicAdd(mod + ((size_t)l * 17 + r) * 3072 + n, acc[r] + bias);
    __syncthreads();
  }
  transpose_tiles(P, tid, lds, 0, (blockIdx.x + gridDim.x - NG % gridDim.x) % gridDim.x, gridDim.x);
}

DI void phase_resnorm(const Params& P, int wv, int l) {
  const int tid = opaque_tid(wv), lane = tid & 63;
  const float* modl = (const float*)(P.ws + WS_MOD) + (size_t)(l < DEPTH ? l : 0) * 17 * 3072;
  const float* modp = (const float*)(P.ws + WS_MOD) + (size_t)(l > 0 ? l - 1 : 0) * 17 * 3072;
  float* ctxs = (float*)(P.ws + WS_CTX);
  u16* h = (u16*)(P.ws + WS_HM);
  const u16* y = (const u16*)(P.ws + WS_Y);
  const bool fin = (l == DEPTH);
  const float* g = fin ? P.final_g : P.norm_g + l * D;
  const int nrows = fin ? ML : MT;
  const int nw = gridDim.x * 8;
  float4 gg[4];
  #pragma unroll
  for (int i = 0; i < 4; ++i) gg[i] = *(const float4*)(g + (i * 64 + lane) * 4);
  for (int row0 = blockIdx.x * 8 + wv; row0 < nrows; row0 += 2 * nw) {
    float4 v[2][4], gt[2][4], sh[2][4], sc[2][4];
    uint2 yv[2][4];
    float* dst[2]; bool ok[2];
    #pragma unroll
    for (int k = 0; k < 2; ++k) {
      const int row = row0 + k * nw;
      ok[k] = row < nrows;
      const int rw = ok[k] ? row : row0;
      const float* src; int rr;
      if (rw < ML) { src = (l <= 1 ? P.x : P.out) + (size_t)rw * D; dst[k] = P.out + (size_t)rw * D; rr = rw >> 12; }
      else { src = (l <= 1 ? P.ctx : ctxs) + (size_t)(rw - ML) * D; dst[k] = ctxs + (size_t)(rw - ML) * D; rr = 16; }
      #pragma unroll
      for (int i = 0; i < 4; ++i) { const f32x4 t = __builtin_nontemporal_load((const f32x4*)(src + (i * 64 + lane) * 4)); v[k][i] = make_float4(t[0], t[1], t[2], t[3]); }
      if (l > 0) {
        #pragma unroll
        for (int i = 0; i < 4; ++i) {
          { const u32x2 t = __builtin_nontemporal_load((const u32x2*)(y + (size_t)rw * D + (i * 64 + lane) * 4)); yv[k][i] = make_uint2(t[0], t[1]); }
          gt[k][i] = *(const float4*)(modp + rr * 3072 + 2048 + (i * 64 + lane) * 4);
        }
      }
      if (!fin) {
        #pragma unroll
        for (int i = 0; i < 4; ++i) {
          sh[k][i] = *(const float4*)(modl + rr * 3072 + (i * 64 + lane) * 4);
          sc[k][i] = *(const float4*)(modl + rr * 3072 + 1024 + (i * 64 + lane) * 4);
        }
      }
    }
    __builtin_amdgcn_sched_barrier(0);
    #pragma unroll
    for (int k = 0; k < 2; ++k) {
      if (!ok[k]) continue;
      const int row = row0 + k * nw;
      float ss = 0.f;
      if (l > 0) {
        #pragma unroll
        for (int i = 0; i < 4; ++i) {
          v[k][i].x += gt[k][i].x * bflo(yv[k][i].x); v[k][i].y += gt[k][i].y * bfhi(yv[k][i].x);
          v[k][i].z += gt[k][i].z * bflo(yv[k][i].y); v[k][i].w += gt[k][i].w * bfhi(yv[k][i].y);
          if (!fin) { f32x4 t; t[0] = v[k][i].x; t[1] = v[k][i].y; t[2] = v[k][i].z; t[3] = v[k][i].w; __builtin_nontemporal_store(t, (f32x4*)(dst[k] + (i * 64 + lane) * 4)); }
        }
      }
      #pragma unroll
      for (int i = 0; i < 4; ++i) ss += v[k][i].x * v[k][i].x + v[k][i].y * v[k][i].y + v[k][i].z * v[k][i].z + v[k][i].w * v[k][i].w;
      ss = wave_sum(ss);
      const float rstd = rsqrtf(ss * (1.f / D) + 1e-6f);
      if (fin) {
        #pragma unroll
        for (int i = 0; i < 4; ++i) {
          const int c = (i * 64 + lane) * 4;
          float4 o; o.x = v[k][i].x * rstd * gg[i].x; o.y = v[k][i].y * rstd * gg[i].y; o.z = v[k][i].z * rstd * gg[i].z; o.w = v[k][i].w * rstd * gg[i].w;
          *(float4*)(dst[k] + c) = o;
        }
      } else {
        #pragma unroll
        for (int i = 0; i < 4; ++i) {
          const int c = (i * 64 + lane) * 4;
          const float a0 = v[k][i].x * rstd * gg[i].x * (1.f + sc[k][i].x) + sh[k][i].x;
          const float a1 = v[k][i].y * rstd * gg[i].y * (1.f + sc[k][i].y) + sh[k][i].y;
          const float a2 = v[k][i].z * rstd * gg[i].z * (1.f + sc[k][i].z) + sh[k][i].z;
          const float a3 = v[k][i].w * rstd * gg[i].w * (1.f + sc[k][i].w) + sh[k][i].w;
          uint2 o; o.x = pk2(a0, a1); o.y = pk2(a2, a3);
          *(uint2*)(h + (size_t)row * D + c) = o;
        }
      }
    }
  }
}

DI void phase_inproj(const Params& P, int wv, int l, char* lds) {
  const u16* W = (const u16*)(P.ws + WS_WIN) + (size_t)l * DP * D;
  const u16* h = (const u16*)(P.ws + WS_HM);
  u16* z = (u16*)(P.ws + WS_Z);
  constexpr int NCT = DP / 256;
  gemm_phase<true>(P, wv, h, W, NTT * NCT, NCT, (LAS unsigned char*)lds,
    [&](const f32x4 (&acc)[2][2][4][2], int pm, int pn, int wr, int wc, int fr, int fq) __attribute__((always_inline)) {
      const int row0 = pm * BM + wr * 64 + fr, cw = wc * 32 + 8 * fq;
      if (pn >= 4 && pn < 10) {
        u16* zp = z + Z_Q + (pn - 4) * 256 + cw;
        #pragma unroll
        for (int ai = 0; ai < 2; ++ai)
        #pragma unroll
          for (int m = 0; m < 4; ++m) {
            u16* rowp = zp + (size_t)(row0 + ai * HALF + m * 16) * ZC;
            #pragma unroll
            for (int bj = 0; bj < 2; ++bj) {
              const f32x4 v0 = acc[ai][bj][m][0], v1 = acc[ai][bj][m][1];
              uint4 o; o.x = pk2(v0[0], v0[1]); o.y = pk2(v0[2], v0[3]); o.z = pk2(v1[0], v1[1]); o.w = pk2(v1[2], v1[3]);
              if (pn < 6) st16_nt(rowp + bj * HALF, o); else *(uint4*)(rowp + bj * HALF) = o;
            }
          }
      } else if (pn == 10 || pn == 11 || pn == 14) {
        u16* zp = z + (pn == 14 ? Z_CFG : Z_NG + (pn - 10) * 256) + cw;
        #pragma unroll
        for (int ai = 0; ai < 2; ++ai)
        #pragma unroll
          for (int m = 0; m < 4; ++m) {
            u16* rowp = zp + (size_t)(row0 + ai * HALF + m * 16) * ZC;
            #pragma unroll
            for (int bj = 0; bj < 2; ++bj) {
              const f32x4 v0 = acc[ai][bj][m][0], v1 = acc[ai][bj][m][1];
              uint4 o; o.x = pk2(silu_f(v0[0]), silu_f(v0[1])); o.y = pk2(silu_f(v0[2]), silu_f(v0[3]));
              o.z = pk2(silu_f(v1[0]), silu_f(v1[1])); o.w = pk2(silu_f(v1[2]), silu_f(v1[3]));
              st16_nt(rowp + bj * HALF, o);
            }
          }
      } else {
        const int mode = (pn < 2) ? 0 : (pn < 4 ? 1 : 2);
        const int ob = (pn < 2) ? Z_SCV + pn * 128 : (pn < 4 ? Z_SCG + (pn - 2) * 128 : Z_CFU + (pn - 12) * 128);
        u16* zp = z + ob + cw;
        #pragma unroll
        for (int ai = 0; ai < 2; ++ai)
        #pragma unroll
          for (int m = 0; m < 4; ++m) {
            float o8[8];
            #pragma unroll
            for (int n = 0; n < 2; ++n)
            #pragma unroll
              for (int j = 0; j < 4; ++j) {
                const float a = acc[ai][0][m][n][j], b = acc[ai][1][m][n][j];
                o8[n * 4 + j] = a * (mode == 0 ? b : (mode == 1 ? silu_f(b) : sigmoid_f(b)));
              }
            uint4 o; o.x = pk2(o8[0], o8[1]); o.y = pk2(o8[2], o8[3]); o.z = pk2(o8[4], o8[5]); o.w = pk2(o8[6], o8[7]);
            st16_nt(zp + (size_t)(row0 + ai * HALF + m * 16) * ZC, o);
          }
      }
    });
}

DI void phase_outproj(const Params& P, int wv, int l, char* lds) {
  const u16* W = (const u16*)(P.ws + WS_WOUT) + (size_t)l * D * D;
  const u16* mm = (const u16*)(P.ws + WS_HM);
  u16* y = (u16*)(P.ws + WS_Y);
  const int ntt = (l == DEPTH - 1) ? (ML / 256) : NTT;
  gemm_phase<true>(P, wv, mm, W, ntt * 4, 4, (LAS unsigned char*)lds,
    [&](const f32x4 (&acc)[2][2][4][2], int pm, int pn, int wr, int wc, int fr, int fq) __attribute__((always_inline)) {
      const int row0 = pm * BM + wr * 64 + fr, col0 = pn * BM + wc * 32 + 8 * fq;
      #pragma unroll
      for (int ai = 0; ai < 2; ++ai)
      #pragma unroll
        for (int m = 0; m < 4; ++m) {
          u16* rowp = y + (size_t)(row0 + ai * HALF + m * 16) * D + col0;
          #pragma unroll
          for (int bj = 0; bj < 2; ++bj) {
            const f32x4 v0 = acc[ai][bj][m][0], v1 = acc[ai][bj][m][1];
            uint4 o; o.x = pk2(v0[0], v0[1]); o.y = pk2(v0[2], v0[3]); o.z = pk2(v1[0], v1[1]); o.w = pk2(v1[2], v1[3]);
            *(uint4*)(rowp + bj * HALF) = o;
          }
        }
    });
  if (l + 1 < DEPTH) {
    const int busy = ntt * 4 - 4 * (int)gridDim.x;
    if (busy > 0 && busy < (int)gridDim.x && (int)blockIdx.x >= busy)
      transpose_tiles(P, opaque_tid(wv), lds, l + 1, (int)blockIdx.x - busy, (int)gridDim.x - busy);
    else if (busy <= 0 || busy >= (int)gridDim.x)
      transpose_tiles(P, opaque_tid(wv), lds, l + 1, (int)blockIdx.x, (int)gridDim.x);
  }
}

constexpr int BIAS_OFF = 832 * 128;
struct AttnTask { int b, h, r0, half, lat; };
DI AttnTask attn_decode(int task) {
  AttnTask t; t.lat = (task < 4096) ? 1 : 0; t.r0 = 0; t.half = 0;
  if (t.lat) { t.b = task >> 8; t.h = (task >> 5) & 7; t.r0 = (task & 31) * 2; }
  else { const int t2 = task - 4096; t.b = t2 >> 4; t.h = (t2 >> 1) & 7; t.half = t2 & 1; }
  return t;
}

DI void attn_loop(const Params& P, int wv, int l, int n_attn, char* lds_g, int r_begin, int r_end) {
  LAS char* lds = (LAS char*)lds_g;
  const u16* z = (const u16*)(P.ws + WS_Z);
  u16* mb = (u16*)(P.ws + WS_HM);
  const int tid = opaque_tid(wv);
  const int G = gridDim.x;
  int task = logical_block() + r_begin * G, round = r_begin;
  if (task >= n_attn || r_begin >= r_end) return;

  int lane, fr, fq, w, st_lds, kl0, kl1, tl[4];
  const u16* zl;
  auto lane_consts = [&](int tq) __attribute__((always_inline)) {
    lane = tq & 63; fr = lane & 15; fq = lane >> 4;
    w = __builtin_amdgcn_readfirstlane(tq >> 6);
    const int st_row = tq >> 3, st_c = tq & 7;
    st_lds = st_row * 128 + ((st_c ^ (((st_row >> 1) & 3) << 1) ^ ((st_row >> 3) & 1)) << 4);
    zl = z + (size_t)st_row * ZC + st_c * 8;
    const int ksw = (((fr >> 1) & 3) << 1) ^ (fr >> 3);
    kl0 = fr * 128 + ((fq ^ ksw) << 4);
    kl1 = fr * 128 + (((fq + 4) ^ ksw) << 4);
    const int q4 = fr >> 2, p4 = fr & 3, trow = 4 * fq + q4, tsw = (((trow >> 1) & 3) << 1) ^ (fq >> 1);
    #pragma unroll
    for (int mbk = 0; mbk < 4; ++mbk) tl[mbk] = trow * 128 + (((2 * mbk + (p4 >> 1)) ^ tsw) << 4) + 8 * (p4 & 1);
  };
  lane_consts(tid);
  typedef LAS s16x4* lds_s16x4_p;
  constexpr float LOG2E = 1.4426950408889634f;
  constexpr float SC2 = 0.125f * LOG2E;

  u32x4 rg[13];
  float brg[2];
  auto load_img = [&](const AttnTask& t, int coloff) __attribute__((always_inline)) {
    const size_t ctxbase = (size_t)ML + t.b * NCTX;
    const int rs0 = clampi(t.r0 - 4, 0, 56);
    #pragma unroll
    for (int i = 0; i < 4; ++i) rg[9 + i] = *(const u32x4*)(zl + (ctxbase + i * 64) * ZC + coloff);
    if (t.lat) {
      #pragma unroll
      for (int i = 0; i < 9; ++i) {
        const int gr = min(rs0 + i, 63);
        rg[i] = *(const u32x4*)(zl + ((size_t)t.b * SEQ + gr * 64) * ZC + coloff);
      }
    }
  };
  auto store_img = [&](const AttnTask& t) __attribute__((always_inline)) {
    if (t.lat) {
      #pragma unroll
      for (int i = 0; i < 9; ++i) *(LAS u32x4*)(lds + st_lds + i * 8192) = rg[i];
    }
    #pragma unroll
    for (int i = 0; i < 4; ++i) *(LAS u32x4*)(lds + st_lds + (9 + i) * 8192) = rg[9 + i];
  };
  auto load_bias = [&](const AttnTask& t) __attribute__((always_inline)) {
    if (t.lat) {
      #pragma unroll
      for (int j = 0; j < 2; ++j) {
        const int id = tid + j * 512, ri = id >> 6, ci = (id & 63) - 16;
        brg[j] = (id < 960 && ci >= 0 && ci < 31) ? P.rpb[((size_t)l * 8 + t.h) * 465 + ri * 31 + ci] * LOG2E : 0.f;
      }
    }
  };

  AttnTask cur = attn_decode(task);
  load_img(cur, Z_K + cur.h * 64);
  load_bias(cur);
  if (wv >= 4) __builtin_amdgcn_s_setprio(1);
  for (;;) {
    { int tq = tid; asm volatile("" : "+v"(tq)); lane_consts(tq); }
    store_img(cur);
    if (cur.lat) {
      ((LAS float*)(lds + BIAS_OFF))[tid] = brg[0];
      if (tid < 960 - 512) ((LAS float*)(lds + BIAS_OFF))[tid + 512] = brg[1];
    }
    load_img(cur, Z_V + cur.h * 64);
    const int b = cur.b, h = cur.h;
    const size_t ctxbase = (size_t)ML + b * NCTX;
    const int rs0 = clampi(cur.r0 - 4, 0, 56);
    int r = 0, c0 = 0, rs = 0, rowoff = 0, cb = 0;
    size_t qtok;
    if (cur.lat) {
      r = cur.r0 + (w >> 2); c0 = 16 * (w & 3); rs = clampi(r - 4, 0, 56); rowoff = rs - rs0; cb = clampi(c0 - 8, 0, 32);
      qtok = (size_t)b * SEQ + r * 64 + c0 + fr;
    } else {
      qtok = ctxbase + cur.half * 128 + w * 16 + fr;
    }
    const int wb = (rowoff * 64 + cb) * 128;
    const int pbx = ((cb >> 3) & 1) << 4;
    const bf16x8 qf0 = *(const bf16x8*)(z + qtok * ZC + Z_Q + h * 64 + fq * 8);
    const bf16x8 qf1 = *(const bf16x8*)(z + qtok * ZC + Z_Q + h * 64 + 32 + fq * 8);
    __syncthreads();

    bf16x8 pc[8], pw[8];
    float mc, lc = 0.f, mw = -1e30f, lw = 0.f;
    {
      f32x4 sc[16];
      float mxc = -1e30f;
      bf16x8 fa[4], fb[4];
      #pragma unroll
      for (int u = 0; u < 2; ++u) {
        fa[2 * u]     = *(const LAS bf16x8*)(lds + 73728 + kl0 + u * 2048);
        fa[2 * u + 1] = *(const LAS bf16x8*)(lds + 73728 + kl1 + u * 2048);
      }
      #pragma unroll
      for (int g = 0; g < 8; ++g) {
        if (g + 1 < 8) {
          #pragma unroll
          for (int u = 0; u < 2; ++u) {
            const bf16x8 x0 = *(const LAS bf16x8*)(lds + 73728 + kl0 + (2 * g + 2 + u) * 2048);
            const bf16x8 x1 = *(const LAS bf16x8*)(lds + 73728 + kl1 + (2 * g + 2 + u) * 2048);
            if (g & 1) { fa[2 * u] = x0; fa[2 * u + 1] = x1; } else { fb[2 * u] = x0; fb[2 * u + 1] = x1; }
          }
        }
        __builtin_amdgcn_sched_barrier(0);
        #pragma unroll
        for (int u = 0; u < 2; ++u) {
          const bf16x8 k0 = (g & 1) ? fb[2 * u] : fa[2 * u];
          const bf16x8 k1 = (g & 1) ? fb[2 * u + 1] : fa[2 * u + 1];
          f32x4 a = {0.f, 0.f, 0.f, 0.f};
          a = __builtin_amdgcn_mfma_f32_16x16x32_bf16(k0, qf0, a, 0, 0, 0);
          a = __builtin_amdgcn_mfma_f32_16x16x32_bf16(k1, qf1, a, 0, 0, 0);
          #pragma unroll
          for (int i = 0; i < 4; ++i) mxc = fmaxf(mxc, a[i]);
          sc[2 * g + u] = a;
        }
        __builtin_amdgcn_sched_barrier(0);
      }
      mxc = fmaxf(mxc, __shfl_xor(mxc, 16));
      mxc = fmaxf(mxc, __shfl_xor(mxc, 32));
      mc = mxc * SC2;
      #pragma unroll
      for (int jj = 0; jj < 8; ++jj) {
        float e[8];
        #pragma unroll
        for (int i = 0; i < 4; ++i) { e[i] = fexp2(sc[2 * jj][i] * SC2 - mc); e[4 + i] = fexp2(sc[2 * jj + 1][i] * SC2 - mc); }
        #pragma unroll
        for (int i = 0; i < 8; ++i) lc += e[i];
        u32x4 bu; bu[0] = pk2(e[0], e[1]); bu[1] = pk2(e[2], e[3]); bu[2] = pk2(e[4], e[5]); bu[3] = pk2(e[6], e[7]);
        pc[jj] = __builtin_bit_cast(bf16x8, bu);
      }
    }
    if (cur.lat) {
      const int qc = c0 + fr, cs = clampi(qc - 8, 0, 48);
      bool vm[4];
      int boff[4];
      const int bci = cb - c0 + 15 + 4 * fq - fr + 16;
      #pragma unroll
      for (int i = 0; i < 4; ++i) { const int kc = cb + 4 * fq + i; vm[i] = (kc >= cs) && (kc < cs + 16); boff[i] = bci + i + (vm[i] ? 0 : 16); }
      const LAS float* bl = (const LAS float*)(lds + BIAS_OFF) + (rs - r + 7) * 64;
      const int wk0 = wb + (kl0 ^ pbx), wk1 = wb + (kl1 ^ pbx);
      f32x4 sw[8];
      float mxw = -1e30f;
      bf16x8 fa[4], fb[4];
      float ba[4], bb[4];
      fa[0] = *(const LAS bf16x8*)(lds + wk0); fa[1] = *(const LAS bf16x8*)(lds + wk1);
      fa[2] = *(const LAS bf16x8*)(lds + wk0 + 2048); fa[3] = *(const LAS bf16x8*)(lds + wk1 + 2048);
      #pragma unroll
      for (int i = 0; i < 4; ++i) ba[i] = bl[boff[i]];
      #pragma unroll
      for (int jj = 0; jj < 8; ++jj) {
        if (jj + 1 < 8) {
          const bf16x8 x0 = *(const LAS bf16x8*)(lds + wk0 + (jj + 1) * 8192), x1 = *(const LAS bf16x8*)(lds + wk1 + (jj + 1) * 8192);
          const bf16x8 x2 = *(const LAS bf16x8*)(lds + wk0 + (jj + 1) * 8192 + 2048), x3 = *(const LAS bf16x8*)(lds + wk1 + (jj + 1) * 8192 + 2048);
          if (jj & 1) { fa[0] = x0; fa[1] = x1; fa[2] = x2; fa[3] = x3; } else { fb[0] = x0; fb[1] = x1; fb[2] = x2; fb[3] = x3; }
          #pragma unroll
          for (int i = 0; i < 4; ++i) { const float t = bl[(jj + 1) * 64 + boff[i]]; if (jj & 1) ba[i] = t; else bb[i] = t; }
        }
        __builtin_amdgcn_sched_barrier(0);
        f32x4 a0 = {0.f, 0.f, 0.f, 0.f}, a1 = {0.f, 0.f, 0.f, 0.f};
        a0 = __builtin_amdgcn_mfma_f32_16x16x32_bf16((jj & 1) ? fb[0] : fa[0], qf0, a0, 0, 0, 0);
        a0 = __builtin_amdgcn_mfma_f32_16x16x32_bf16((jj & 1) ? fb[1] : fa[1], qf1, a0, 0, 0, 0);
        a1 = __builtin_amdgcn_mfma_f32_16x16x32_bf16((jj & 1) ? fb[2] : fa[2], qf0, a1, 0, 0, 0);
        a1 = __builtin_amdgcn_mfma_f32_16x16x32_bf16((jj & 1) ? fb[3] : fa[3], qf1, a1, 0, 0, 0);
        f32x4 a;
        #pragma unroll
        for (int i = 0; i < 4; ++i) {
          const float bias = (jj & 1) ? bb[i] : ba[i];
          a[i] = (vm[i] ? a0[i] : a1[i]) * SC2 + bias;
          mxw = fmaxf(mxw, a[i]);
        }
        sw[jj] = a;
        __builtin_amdgcn_sched_barrier(0);
      }
      mxw = fmaxf(mxw, __shfl_xor(mxw, 16));
      mxw = fmaxf(mxw, __shfl_xor(mxw, 32));
      mw = mxw;
      #pragma unroll
      for (int jj = 0; jj < 8; ++jj) {
        float e0[4], e1[4];
        #pragma unroll
        for (int i = 0; i < 4; ++i) {
          const float e = fexp2(sw[jj][i] - mw);
          lw += e;
          e0[i] = vm[i] ? e : 0.f; e1[i] = vm[i] ? 0.f : e;
        }
        u32x4 bu; bu[0] = pk2(e0[0], e0[1]); bu[1] = pk2(e0[2], e0[3]); bu[2] = pk2(e1[0], e1[1]); bu[3] = pk2(e1[2], e1[3]);
        pw[jj] = __builtin_bit_cast(bf16x8, bu);
      }
    } else {
      #pragma unroll
      for (int jj = 0; jj < 8; ++jj) pw[jj] = (bf16x8){0, 0, 0, 0, 0, 0, 0, 0};
    }
    lc += __shfl_xor(lc, 16); lc += __shfl_xor(lc, 32);
    lw += __shfl_xor(lw, 16); lw += __shfl_xor(lw, 32);
    const float mfin = fmaxf(mc, mw);
    const float fc = fexp2(mc - mfin), fw = fexp2(mw - mfin);
    const float inv = __builtin_amdgcn_rcpf(lc * fc + lw * fw);
    const float gc = fc * inv, gw = fw * inv;

    __syncthreads();
    store_img(cur);
    const int ntask = task + G;
    const bool has_next = (ntask < n_attn) && (round + 1 < r_end);
    AttnTask nxt = cur;
    if (has_next) { nxt = attn_decode(ntask); load_img(nxt, Z_K + nxt.h * 64); load_bias(nxt); }
    __syncthreads();

    uint2 gv[4];
    #pragma unroll
    for (int mbk = 0; mbk < 4; ++mbk) gv[mbk] = *(const uint2*)(z + qtok * ZC + Z_NG + h * 64 + 16 * mbk + 4 * fq);
    f32x4 oc[4], ow[4];
    #pragma unroll
    for (int mbk = 0; mbk < 4; ++mbk) { f32x4 zz = {0.f, 0.f, 0.f, 0.f}; oc[mbk] = zz; ow[mbk] = zz; }
    {
      s16x4 r3[3][8];
      #pragma unroll
      for (int p = 0; p < 2; ++p)
      #pragma unroll
        for (int mbk = 0; mbk < 4; ++mbk) {
          r3[p][2 * mbk]     = __builtin_amdgcn_ds_read_tr16_b64_v4i16((lds_s16x4_p)(lds + 73728 + tl[mbk] + p * 4096));
          r3[p][2 * mbk + 1] = __builtin_amdgcn_ds_read_tr16_b64_v4i16((lds_s16x4_p)(lds + 73728 + tl[mbk] + p * 4096 + 2048));
        }
      #pragma unroll
      for (int jj = 0; jj < 8; ++jj) {
        if (jj + 2 < 8) {
          #pragma unroll
          for (int mbk = 0; mbk < 4; ++mbk) {
            r3[(jj + 2) % 3][2 * mbk]     = __builtin_amdgcn_ds_read_tr16_b64_v4i16((lds_s16x4_p)(lds + 73728 + tl[mbk] + (jj + 2) * 4096));
            r3[(jj + 2) % 3][2 * mbk + 1] = __builtin_amdgcn_ds_read_tr16_b64_v4i16((lds_s16x4_p)(lds + 73728 + tl[mbk] + (jj + 2) * 4096 + 2048));
          }
        }
        __builtin_amdgcn_sched_barrier(0);
        #pragma unroll
        for (int mbk = 0; mbk < 4; ++mbk) {
          const bf16x8 av = __builtin_shufflevector(r3[jj % 3][2 * mbk], r3[jj % 3][2 * mbk + 1], 0, 1, 2, 3, 4, 5, 6, 7);
          oc[mbk] = __builtin_amdgcn_mfma_f32_16x16x32_bf16(av, pc[jj], oc[mbk], 0, 0, 0);
        }
        __builtin_amdgcn_sched_barrier(0);
      }
    }
    if (cur.lat) {
      s16x4 r3[3][8];
      const int tw = wb;
      #pragma unroll
      for (int p = 0; p < 2; ++p)
      #pragma unroll
        for (int mbk = 0; mbk < 4; ++mbk) {
          const int ta = tw + (tl[mbk] ^ pbx) + p * 8192;
          r3[p][2 * mbk]     = __builtin_amdgcn_ds_read_tr16_b64_v4i16((lds_s16x4_p)(lds + ta));
          r3[p][2 * mbk + 1] = __builtin_amdgcn_ds_read_tr16_b64_v4i16((lds_s16x4_p)(lds + ta + 2048));
        }
      #pragma unroll
      for (int jj = 0; jj < 8; ++jj) {
        if (jj + 2 < 8) {
          #pragma unroll
          for (int mbk = 0; mbk < 4; ++mbk) {
            const int ta = tw + (tl[mbk] ^ pbx) + (jj + 2) * 8192;
            r3[(jj + 2) % 3][2 * mbk]     = __builtin_amdgcn_ds_read_tr16_b64_v4i16((lds_s16x4_p)(lds + ta));
            r3[(jj + 2) % 3][2 * mbk + 1] = __builtin_amdgcn_ds_read_tr16_b64_v4i16((lds_s16x4_p)(lds + ta + 2048));
          }
        }
        __builtin_amdgcn_sched_barrier(0);
        #pragma unroll
        for (int mbk = 0; mbk < 4; ++mbk) {
          const bf16x8 av = __builtin_shufflevector(r3[jj % 3][2 * mbk], r3[jj % 3][2 * mbk + 1], 0, 1, 2, 3, 4, 5, 6, 7);
          ow[mbk] = __builtin_amdgcn_mfma_f32_16x16x32_bf16(av, pw[jj], ow[mbk], 0, 0, 0);
        }
        __builtin_amdgcn_sched_barrier(0);
      }
    }
    #pragma unroll
    for (int mbk = 0; mbk < 4; ++mbk) {
      const int dh = 16 * mbk + 4 * fq;
      const float g0 = bflo(gv[mbk].x), g1 = bfhi(gv[mbk].x), g2 = bflo(gv[mbk].y), g3 = bfhi(gv[mbk].y);
      const float o0 = oc[mbk][0] * gc + ow[mbk][0] * gw, o1 = oc[mbk][1] * gc + ow[mbk][1] * gw;
      const float o2 = oc[mbk][2] * gc + ow[mbk][2] * gw, o3 = oc[mbk][3] * gc + ow[mbk][3] * gw;
      uint2 ov; ov.x = pk2(o0 * g0, o1 * g1); ov.y = pk2(o2 * g2, o3 * g3);
      *(uint2*)(mb + qtok * D + 256 + h * 64 + dh) = ov;
    }
    __syncthreads();
    if (!has_next) break;
    cur = nxt; task = ntask; ++round;
  }
  __builtin_amdgcn_s_setprio(0);
}

struct ConvTask { int L, t0; size_t tokbase; };
DI ConvTask conv_decode(int task) {
  ConvTask t;
  if (task < 1024) { const int b = task >> 6; t.t0 = (task & 63) * 64; t.L = SEQ; t.tokbase = (size_t)b * SEQ; }
  else { const int t2 = task - 1024; const int b = t2 >> 2; t.t0 = (t2 & 3) * 64; t.L = NCTX; t.tokbase = (size_t)ML + b * NCTX; }
  return t;
}

DI void conv_loop(const Params& P, int wv, int l, int n_conv, int first, char* lds, int max_iters) {
  const u16* z = (const u16*)(P.ws + WS_Z);
  u16* mb = (u16*)(P.ws + WS_HM);
  const int tid = opaque_tid(wv);
  const int G = gridDim.x;
  int task = first, iters = 1;
  if (task >= n_conv) return;
  u16* U = (u16*)lds;
  float* O = (float*)(lds + 49152);

  uint4 pv[6];
  auto load_pq = [&](const ConvTask& t, int tq_) __attribute__((always_inline)) {
    #pragma unroll
    for (int it = 0; it < 6; ++it) {
      const int id = tq_ + it * 512, trow = id >> 5, cgA = id & 31;
      const int tt = t.t0 - 15 + trow;
      const bool ok = (id < 94 * 32) && tt >= 0 && tt < t.L;
      const u16* zr = z + (t.tokbase + (ok ? tt : t.t0)) * ZC;
      pv[it] = *(const uint4*)(zr + Z_CFU + cgA * 8);
    }
  };
  ConvTask cur = conv_decode(task);
  load_pq(cur, tid);

  for (;;) {
    const int L = cur.L, t0 = cur.t0; const size_t tokbase = cur.tokbase;
    int lq = l, tq = tid;
    asm volatile("" : "+s"(lq), "+v"(tq));
    const int c = tq & 255, run = tq >> 8;
    const int cg8 = tq & 31, srun = tq >> 5;
    const int lane = tq & 63, w = tq >> 6;
    #pragma unroll
    for (int it = 0; it < 6; ++it) {
      const int id = tq + it * 512, trow = id >> 5, cgA = id & 31;
      const int tt = t0 - 15 + trow;
      const bool ok = tt >= 0 && tt < L;
      if (id < 94 * 32) {
        uint4 o = pv[it];
        if (!ok) o = make_uint4(0u, 0u, 0u, 0u);
        *(uint4*)(U + trow * 256 + cgA * 8) = o;
      }
    }
    {
    uint4 hv[6], bv[4];
    #pragma unroll
    for (int jj = 0; jj < 6; ++jj) {
      const int tt = t0 + srun * 4 - 1 + jj;
      const bool ok = tt >= 0 && tt < L;
      const u16* zr = z + (tokbase + (ok ? tt : t0)) * ZC;
      hv[jj] = *(const uint4*)(zr + Z_SCV + cg8 * 8);
    }
    #pragma unroll
    for (int i = 0; i < 4; ++i) {
      const u16* zr = z + (tokbase + t0 + srun * 4 + i) * ZC;
      bv[i] = *(const uint4*)(zr + Z_SCG + cg8 * 8);
    }
      const float* wsc = P.conv_sc + (size_t)lq * 3 * 256 + cg8 * 8;
      float w0[8], w1[8], w2[8];
      #pragma unroll
      for (int e = 0; e < 8; ++e) { w0[e] = wsc[e]; w1[e] = wsc[256 + e]; w2[e] = wsc[512 + e]; }
      float v[6][8];
      #pragma unroll
      for (int jj = 0; jj < 6; ++jj) {
        const int tt = t0 + srun * 4 - 1 + jj;
        const bool ok = tt >= 0 && tt < L;
        float hf[8]; unpack8(hv[jj], hf);
        #pragma unroll
        for (int e = 0; e < 8; ++e) v[jj][e] = ok ? hf[e] : 0.f;
      }
      #pragma unroll
      for (int i = 0; i < 4; ++i) {
        const size_t tok = tokbase + t0 + srun * 4 + i;
        float bf[8], of[8]; unpack8(bv[i], bf);
        #pragma unroll
        for (int e = 0; e < 8; ++e)
          of[e] = bf[e] * (w0[e] * v[i][e] + w1[e] * v[i + 1][e] + w2[e] * v[i + 2][e]);
        uint4 ov; ov.x = pk2(of[0], of[1]); ov.y = pk2(of[2], of[3]); ov.z = pk2(of[4], of[5]); ov.w = pk2(of[6], of[7]);
        *(uint4*)(mb + tok * D + cg8 * 8) = ov;
      }
    }

    __syncthreads();

    const int ntask = task + G;
    const bool has_next = (ntask < n_conv) && (iters < max_iters);
    ConvTask nxt = cur;
    if (has_next) { nxt = conv_decode(ntask); load_pq(nxt, tq); }

    {
      const float* wcf = P.conv_cf + (size_t)lq * 31 * 256 + c;
      float wk[31];
      #pragma unroll
      for (int k = 0; k < 31; ++k) wk[k] = wcf[k * 256];
      f32x2 W2[32];
      #pragma unroll
      for (int k = 0; k < 32; ++k) { W2[k][0] = (k < 31) ? wk[k] : 0.f; W2[k][1] = (k > 0) ? wk[k - 1] : 0.f; }
      const float bias = P.conv_cf_b[lq * 256 + c];
      #pragma unroll 1
      for (int ob = 0; ob < 4; ++ob) {
        const int r0 = run * 32 + ob * 8;
        const u16* up = U + r0 * 256 + c;
        f32x2 acc2[4];
        #pragma unroll
        for (int p = 0; p < 4; ++p) { acc2[p][0] = bias; acc2[p][1] = bias; }
        unsigned short raw[38];
        #pragma unroll
        for (int jj = 0; jj < 38; ++jj) raw[jj] = up[jj * 256];
        __builtin_amdgcn_sched_barrier(0);
        #pragma unroll
        for (int jj = 0; jj < 38; ++jj) {
          const float val = __uint_as_float(((unsigned)raw[jj]) << 16);
          f32x2 v2; v2[0] = val; v2[1] = val;
          #pragma unroll
          for (int p = 0; p < 4; ++p) {
            if (jj - 2 * p >= 0 && jj - 2 * p <= 31) acc2[p] = W2[jj - 2 * p] * v2 + acc2[p];
          }
        }
        #pragma unroll
        for (int p = 0; p < 4; ++p) { O[(r0 + 2 * p) * 256 + c] = acc2[p][0]; O[(r0 + 2 * p + 1) * 256 + c] = acc2[p][1]; }
      }
    }
    uint2 zg[8];
    #pragma unroll
    for (int i = 0; i < 8; ++i) zg[i] = *(const uint2*)(z + (tokbase + t0 + w * 8 + i) * ZC + Z_CFG + lane * 4);
    __syncthreads();

    {
      const float4 lg = *(const float4*)(P.ln_cf_g + lq * 256 + lane * 4);
      const float4 lb = *(const float4*)(P.ln_cf_b + lq * 256 + lane * 4);
      float4 xva[8];
      #pragma unroll
      for (int i = 0; i < 8; ++i) xva[i] = *(const float4*)(O + (w * 8 + i) * 256 + lane * 4);
      __builtin_amdgcn_sched_barrier(0);
      #pragma unroll
      for (int i = 0; i < 8; ++i) {
        const int ti = w * 8 + i;
        const float4 xv = xva[i];
        const float s = wave_sum(xv.x + xv.y + xv.z + xv.w);
        const float mu = s * (1.f / 256.f);
        float d0 = xv.x - mu, d1 = xv.y - mu, d2 = xv.z - mu, d3 = xv.w - mu;
        const float q = wave_sum(d0 * d0 + d1 * d1 + d2 * d2 + d3 * d3);
        const float rstd = rsqrtf(q * (1.f / 256.f) + 1e-5f);
        const size_t tok = tokbase + t0 + ti;
        float y0 = silu_f(d0 * rstd * lg.x + lb.x) * bflo(zg[i].x);
        float y1 = silu_f(d1 * rstd * lg.y + lb.y) * bfhi(zg[i].x);
        float y2 = silu_f(d2 * rstd * lg.z + lb.z) * bflo(zg[i].y);
        float y3 = silu_f(d3 * rstd * lg.w + lb.w) * bfhi(zg[i].y);
        uint2 ov; ov.x = pk2(y0, y1); ov.y = pk2(y2, y3);
        *(uint2*)(mb + tok * D + 768 + lane * 4) = ov;
      }
    }
    if (!has_next) break;
    cur = nxt; task = ntask; ++iters;
  }
  __syncthreads();
}

DI void phase_mixer(const Params& P, int wv, int l, char* lds, int which = 3) {
  const bool last = (l == DEPTH - 1);
  const int n_attn = last ? 4096 : 4352;
  const int n_conv = last ? 1024 : 1088;
  const int G = gridDim.x;
  const int nr = (n_attn + G - 1) / G;
  const int L = logical_block();
  int l2 = l;
  asm volatile("" : "+s"(l2));
  if (which & 1) attn_loop(P, wv, l2, n_attn, lds, 0, nr);
  asm volatile("" : "+s"(l2));
  if (which & 2) conv_loop(P, wv, l2, n_conv, L, lds, 1000);
}

#define XB_TMO      128
#define XB_XCNT(j)  (256  + 64 * (j))
#define XB_XSUB(j)  (1280 + 64 * (j))
#define XB_XGEN(j)  (2304 + 64 * (j))
#define XB_TOP      3328
#define XB_TOPGEN   3392
#define XCD_BAR_WORDS 3456
#define XB_SPIN_CAP (1u << 18)
DI unsigned xb_ld(unsigned* p)              { return __hip_atomic_load(p, __ATOMIC_RELAXED, __HIP_MEMORY_SCOPE_AGENT); }
DI unsigned xb_add(unsigned* p, unsigned v) { return __hip_atomic_fetch_add(p, v, __ATOMIC_RELAXED, __HIP_MEMORY_SCOPE_AGENT); }
DI unsigned xb_xcc_id() { return (unsigned)__builtin_amdgcn_s_getreg((3 << 11) | 20) & 0xFu; }
#define XB_SPIN(cond, bar) do { unsigned _sp = 0; while (cond) { __builtin_amdgcn_s_sleep(1); \
    if ((++_sp & 255u) == 0u) { if (xb_ld(&(bar)[XB_TMO])) break; if (_sp > XB_SPIN_CAP) { atomicAdd(&(bar)[XB_TMO], 1u); break; } } } } while (0)
struct XcdBarrier { unsigned* bar; unsigned x; volatile LAS unsigned* st; };
DI XcdBarrier xcd_barrier_post(unsigned* bar, volatile LAS unsigned* st) {
  XcdBarrier b; b.bar = bar; b.x = xb_xcc_id(); b.st = st;
  if (threadIdx.x == 0) (void)xb_add(&bar[XB_XCNT(b.x)], 1u);
  return b;
}
DI void xcd_barrier_complete(unsigned* bar, unsigned x, unsigned& nloc, unsigned& nx) {
  const unsigned G = gridDim.x * gridDim.y * gridDim.z;
  unsigned sum, cnt, mine, sp = 0u;
  for (;;) {
    sum = 0u; cnt = 0u; mine = 0u;
    #pragma unroll
    for (unsigned j = 0; j < 16; ++j) { const unsigned c = xb_ld(&bar[XB_XCNT(j)]); sum += c; cnt += (c > 0u) ? 1u : 0u; mine = (j == x) ? c : mine; }
    if (sum == G) break;
    __builtin_amdgcn_s_sleep(1);
    if ((++sp & 255u) == 0u) { if (xb_ld(&bar[XB_TMO])) break; if (sp > XB_SPIN_CAP) { atomicAdd(&bar[XB_TMO], 1u); break; } }
  }
  nloc = mine > 0u ? mine : 1u; nx = cnt > 0u ? cnt : 1u;
}
DI void xcd_barrier(const XcdBarrier& b) {
  asm volatile("s_waitcnt vmcnt(0)" ::: "memory");
  __syncthreads();
  if (threadIdx.x == 0) {
    unsigned* bar = b.bar;
    __builtin_amdgcn_s_waitcnt(0);
    unsigned nloc = b.st[0], nx = b.st[1];
    if (nloc == 0u) { xcd_barrier_complete(bar, b.x, nloc, nx); b.st[0] = nloc; b.st[1] = nx; }
    const unsigned old = xb_add(&bar[XB_XSUB(b.x)], 1u);
    const unsigned gen = old / nloc;
    if (old + 1u == (gen + 1u) * nloc) {
      __builtin_amdgcn_fence(__ATOMIC_RELEASE, "agent");
      asm volatile("s_waitcnt vmcnt(0)" ::: "memory");
      const unsigned og = xb_add(&bar[XB_TOP], 1u);
      const unsigned tg = og / nx;
      if (og + 1u == (tg + 1u) * nx) xb_add(&bar[XB_TOPGEN], 1u);
      else XB_SPIN(xb_ld(&bar[XB_TOPGEN]) == tg, bar);
      __builtin_amdgcn_fence(__ATOMIC_ACQUIRE, "agent");
      xb_add(&bar[XB_XGEN(b.x)], 1u);
      asm volatile("s_waitcnt vmcnt(0)" ::: "memory");
    } else {
      XB_SPIN(xb_ld(&bar[XB_XGEN(b.x)]) == gen, bar);
      __builtin_amdgcn_fence(__ATOMIC_ACQUIRE, "agent");
      asm volatile("s_waitcnt vmcnt(0)" ::: "memory");
    }
  }
  __syncthreads();
}

constexpr int NPHASE = 18;
template <bool COOP>
__global__ void __launch_bounds__(512) mk_kernel(Params P, int ph_lo, int ph_hi) {
  extern __shared__ __attribute__((aligned(16))) char lds[];
  const int wv = __builtin_amdgcn_readfirstlane((int)(threadIdx.x >> 6));
  XcdBarrier xb;
  if (COOP) {
    volatile LAS unsigned* st = (volatile LAS unsigned*)((LAS char*)lds + LDS_WORK);
    if (threadIdx.x == 0) { st[0] = 0u; st[1] = 0u; }
    __syncthreads();
    xb = xcd_barrier_post((unsigned*)(P.ws + WS_BAR), st);
  }
  for (int ph = ph_lo; ph < ph_hi; ++ph) {
    if (ph == 0) phase0(P, wv, lds);
    else if (ph == NPHASE - 1) phase_resnorm(P, wv, DEPTH);
    else {
      const int l = (ph - 1) >> 2, s = (ph - 1) & 3;
      if (s == 0) { phase_resnorm(P, wv, l); }
      else if (s == 1) { phase_inproj(P, wv, l, lds); if (PROBE == 2) { cg::this_grid().sync(); phase_inproj(P, wv, l, lds); } }
      else if (s == 2) { phase_mixer(P, wv, l, lds); if (PROBE == 4) { cg::this_grid().sync(); phase_mixer(P, wv, l, lds, 1); } if (PROBE == 5) { cg::this_grid().sync(); phase_mixer(P, wv, l, lds, 2); } }
      else { phase_outproj(P, wv, l, lds); if (PROBE == 6) { cg::this_grid().sync(); phase_outproj(P, wv, l, lds); } }
    }
    if (COOP) { if (ph + 1 < ph_hi) {
      if (ph_hi > NPHASE) cg::this_grid().sync(); else xcd_barrier(xb);
    } }
  }
}

extern "C" void kernel_launch(void* const* d_in, const int* in_sizes, int n_in, void* d_out, int out_size,
                              void* d_ws, size_t ws_size, hipStream_t stream) {
  static int grid = 0;
  if (grid == 0) {
    if (n_in != 16 || out_size != ML * D || ws_size < WS_END) {
      fprintf(stderr, "kernel_launch: unexpected shapes n_in %d out %d ws %zu (need %zu)\n", n_in, out_size, ws_size, (size_t)WS_END);
      grid = -1; return;
    }
    int dev = 0, cus = 0, per_cu = 0;
    hipGetDevice(&dev);
    hipDeviceGetAttribute(&cus, hipDeviceAttributeMultiprocessorCount, dev);
    const void* fn = MK_COOP ? (const void*)mk_kernel<true> : (const void*)mk_kernel<false>;
    if (hipFuncSetAttribute(fn, hipFuncAttributeMaxDynamicSharedMemorySize, LDS_BYTES) != hipSuccess) {
      fprintf(stderr, "kernel_launch: hipFuncSetAttribute failed\n"); grid = -1; return;
    }
    if (hipOccupancyMaxActiveBlocksPerMultiprocessor(&per_cu, fn, 512, LDS_BYTES) != hipSuccess || per_cu < 1) {
      fprintf(stderr, "kernel_launch: occupancy query gave %d\n", per_cu); per_cu = 1;
    }
    (void)hipGetLastError();
    grid = cus * 1;
  }
  if (grid < 0) return;
  Params p{};
  p.x = (const float*)d_in[0]; p.c = (const float*)d_in[1]; p.ctx = (const float*)d_in[2]; p.c_ctx = (const float*)d_in[3];
  p.norm_g = (const float*)d_in[4]; p.w_ada = (const float*)d_in[5]; p.b_ada = (const float*)d_in[6]; p.w_in = (const float*)d_in[7];
  p.conv_sc = (const float*)d_in[8]; p.rpb = (const float*)d_in[9]; p.conv_cf = (const float*)d_in[10]; p.conv_cf_b = (const float*)d_in[11];
  p.ln_cf_g = (const float*)d_in[12]; p.ln_cf_b = (const float*)d_in[13]; p.w_out = (const float*)d_in[14]; p.final_g = (const float*)d_in[15];
  p.out = (float*)d_out; p.ws = (unsigned char*)d_ws;
  hipMemsetAsync((char*)d_ws + WS_MOD, 0, MOD_BYTES + XCD_BAR_WORDS * 4, stream);
#if MK_COOP
  int lo = 0, hi = NPHASE;
  void* args[] = {&p, &lo, &hi};
  hipError_t e = hipLaunchCooperativeKernel((const void*)mk_kernel<true>, dim3(grid), dim3(512), args, LDS_BYTES, stream);
  if (e != hipSuccess) fprintf(stderr, "cooperative launch failed: %s (grid %d)\n", hipGetErrorString(e), grid);
#else
  for (int ph = 0; ph < NPHASE; ++ph)
    hipLaunchKernelGGL(mk_kernel<false>, dim3(grid), dim3(512), LDS_BYTES, stream, p, ph, ph + 1);
#endif
}
```

```cpp
#include <hip/hip_runtime.h>
#include <hip/hip_cooperative_groups.h>
#include <cstdio>
namespace cg = cooperative_groups;

#ifndef PROBE
#define PROBE 0
#endif
#ifndef MK_COOP
#define MK_COOP 1
#endif

typedef unsigned short u16;
using bf16x8 = __attribute__((ext_vector_type(8))) short;
using s16x4  = __attribute__((ext_vector_type(4))) short;
using f32x4  = __attribute__((ext_vector_type(4))) float;
using u32x4  = __attribute__((ext_vector_type(4))) unsigned;
using f32x2  = __attribute__((ext_vector_type(2))) float;
using u32x2  = __attribute__((ext_vector_type(2))) unsigned;
typedef __attribute__((ext_vector_type(2))) __bf16 bf2_t;
#define DI __device__ __forceinline__

constexpr int D = 1024, NB = 16, SEQ = 4096, NCTX = 256, DP = 3840, DEPTH = 4;
constexpr int ZC = 3072, Z_SCV = 0, Z_SCG = 256, Z_Q = 512, Z_K = 1024, Z_V = 1536, Z_NG = 2048, Z_CFU = 2560, Z_CFG = 2816;
constexpr int ML = NB * SEQ;
constexpr int MC = NB * NCTX;
constexpr int MT = ML + MC;
constexpr int NTT = MT / 256;
constexpr int LDS_WORK = 131072;
constexpr int LDS_BYTES = LDS_WORK + 16;

constexpr size_t WS_WIN  = 0;
constexpr size_t WS_WOUT = WS_WIN + (size_t)DEPTH * DP * D * 2;
constexpr size_t WS_MOD  = WS_WOUT + (size_t)DEPTH * D * D * 2;
constexpr size_t MOD_BYTES = (size_t)DEPTH * 17 * 3072 * 4;
constexpr size_t WS_BAR  = WS_MOD + MOD_BYTES;
constexpr size_t WS_CTX  = WS_MOD + 1048576;
constexpr size_t WS_HM   = WS_CTX + (size_t)MC * D * 4;
constexpr size_t WS_Z    = WS_HM + (size_t)MT * D * 2;
constexpr size_t WS_Y    = WS_Z + (size_t)MT * DP * 2;
constexpr size_t WS_END  = WS_Y + (size_t)MT * D * 2;

struct Params {
  const float *x, *c, *ctx, *c_ctx, *norm_g, *w_ada, *b_ada, *w_in, *conv_sc, *rpb, *conv_cf, *conv_cf_b, *ln_cf_g, *ln_cf_b, *w_out, *final_g;
  float* out;
  unsigned char* ws;
};

DI float fexp2(float v) { return __builtin_amdgcn_exp2f(v); }
DI float sigmoid_f(float v) { return __builtin_amdgcn_rcpf(1.f + fexp2(-1.4426950408889634f * v)); }
DI float silu_f(float v) { return v * sigmoid_f(v); }
DI unsigned pk2(float a, float b) { bf2_t v; v[0] = (__bf16)a; v[1] = (__bf16)b; return __builtin_bit_cast(unsigned, v); }
DI float bflo(unsigned w) { return __uint_as_float(w << 16); }
DI float bfhi(unsigned w) { return __uint_as_float(w & 0xffff0000u); }
DI void unpack8(const uint4& v, float* f) {
  f[0] = bflo(v.x); f[1] = bfhi(v.x); f[2] = bflo(v.y); f[3] = bfhi(v.y);
  f[4] = bflo(v.z); f[5] = bfhi(v.z); f[6] = bflo(v.w); f[7] = bfhi(v.w);
}
DI int opaque_tid(int wv) {
  unsigned m = ~0u;
  asm volatile("" : "+s"(m));
  int t = wv * 64 + (int)__builtin_amdgcn_mbcnt_hi(m, __builtin_amdgcn_mbcnt_lo(m, 0u));
  asm volatile("" : "+v"(t)); return t;
}
DI void st16_wt(void* p, const uint4& v) {
  u32x4 d; d[0] = v.x; d[1] = v.y; d[2] = v.z; d[3] = v.w;
  asm volatile("global_store_dwordx4 %0, %1, off sc1" :: "v"(p), "v"(d) : "memory");
}
template <int CTRL, int RMASK> DI float dpp0(float x) { return __int_as_float(__builtin_amdgcn_update_dpp(0, __float_as_int(x), CTRL, RMASK, 0xf, false)); }
DI float wave_sum(float x) {
  x += dpp0<0xB1, 0xf>(x);
  x += dpp0<0x4E, 0xf>(x);
  x += dpp0<0x124, 0xf>(x);
  x += dpp0<0x128, 0xf>(x);
  x += dpp0<0x142, 0xa>(x);
  x += dpp0<0x143, 0xc>(x);
  return __int_as_float(__builtin_amdgcn_readlane(__float_as_int(x), 63));
}
DI void st16_nt(void* p, const uint4& v) {
  u32x4 d; d[0] = v.x; d[1] = v.y; d[2] = v.z; d[3] = v.w;
  __builtin_nontemporal_store(d, (u32x4*)p);
}
DI uint4 ld16_nt(const void* p) { const u32x4 t = __builtin_nontemporal_load((const u32x4*)p); return make_uint4(t[0], t[1], t[2], t[3]); }
DI uint2 ld8_nt(const void* p) { const u32x2 t = __builtin_nontemporal_load((const u32x2*)p); return make_uint2(t[0], t[1]); }
DI int clampi(int v, int lo, int hi) { return v < lo ? lo : (v > hi ? hi : v); }

#define LAS __attribute__((address_space(3)))
constexpr int BM = 256, BK = 64, HALF = 128, HTB = HALF * BK * 2;
DI int lds_byte(int r, int c) { const int st = (r >> 4) * 2 + (c >> 5), rr = r & 15, cc = c & 31, ob = rr * 64 + cc * 2; return st * 1024 + (ob ^ (((ob >> 9) & 1) << 5)); }
DI void stage_rc(int b, int& R, int& C) { const int st = b / 1024, sb = b % 1024, swz = sb ^ (((sb >> 9) & 1) << 5); R = (st >> 1) * 16 + swz / 64; C = (st & 1) * 32 + (swz % 64) / 2; }
DI int perm32(int rho) { const int n = rho >> 4, i = rho & 15; return 8 * (i >> 2) + 4 * n + (i & 3); }

DI int win_src_col(int n) {
  const int pn = n >> 8, r = n & 255, half = r >> 7, q = r & 127;
  if (pn == 0 || pn == 1) return (half ? 512 : 0) + pn * 128 + q;
  if (pn == 2 || pn == 3) return (half ? 768 : 256) + (pn - 2) * 128 + q;
  if (pn == 12 || pn == 13) return (half ? 3328 : 3072) + (pn - 12) * 128 + q;
  return n;
}

DI int logical_block() {
  int g = gridDim.x;
  if ((g & 7) == 0) return (blockIdx.x & 7) * (g >> 3) + (blockIdx.x >> 3);
  return blockIdx.x;
}

template <bool PERM, class Epi>
DI void gemm_phase(const Params& P, int wv, const u16* __restrict__ Aact, const u16* __restrict__ Wt, int ntiles, int nct, LAS unsigned char* lds, Epi&& E) {
  constexpr int K = 1024, nt = K / BK;
  const int tid = opaque_tid(wv), wid = tid >> 6, lane = tid & 63, wr = wid >> 2, wc = wid & 3, fr = lane & 15, fq = lane >> 4;
  const int G = gridDim.x;
  unsigned voffA[2], voffB[2];
  #pragma unroll
  for (int i = 0; i < 2; ++i) { int R, C; stage_rc(tid * 16 + i * 8192, R, C); const int Rb = PERM ? ((R & ~31) + perm32(R & 31)) : R;
    voffA[i] = (unsigned)(R * K + C) * 2u; voffB[i] = (unsigned)(Rb * K + C) * 2u; }
  const size_t kstep = (size_t)(BK * 2), hstep = (size_t)HALF * K * 2, tstep = 2 * hstep;
  const unsigned ldsw = (unsigned)wid * 1024u;
  const int aoff = lds_byte(wr * 64 + fr, fq * 8), boff = lds_byte(wc * 32 + fr, fq * 8);
  #define G_SA(b, h) (((b) * 2 + (h)) * HTB)
  #define G_SB(b, h) ((4 + (b) * 2 + (h)) * HTB)
  #define G_STAGE(bufoff, gbase, voff) do { _Pragma("unroll") for (int _i = 0; _i < 2; ++_i) \
      __builtin_amdgcn_global_load_lds((const unsigned*)((const char*)(gbase) + (voff)[_i]), (LAS unsigned*)(lds + (bufoff) + ldsw + _i * 8192), 16, 0, 0); } while (0)
  #define G_LDA(dst, b, h) do { _Pragma("unroll") for (int m = 0; m < 4; ++m) _Pragma("unroll") for (int k = 0; k < 2; ++k) dst[m][k] = *(const LAS bf16x8*)(lds + G_SA(b, h) + aoff + m * 2048 + k * 1024); } while (0)
  #define G_LDB(dst, b, h) do { _Pragma("unroll") for (int n = 0; n < 2; ++n) _Pragma("unroll") for (int k = 0; k < 2; ++k) dst[n][k] = *(const LAS bf16x8*)(lds + G_SB(b, h) + boff + n * 2048 + k * 1024); } while (0)
  #define G_MMA(ai, bj, At, Bt) do { __builtin_amdgcn_s_setprio(1); _Pragma("unroll") for (int m = 0; m < 4; ++m) _Pragma("unroll") for (int n = 0; n < 2; ++n) _Pragma("unroll") for (int k = 0; k < 2; ++k) \
      acc[ai][bj][m][n] = __builtin_amdgcn_mfma_f32_16x16x32_bf16(Bt[n][k], At[m][k], acc[ai][bj][m][n], 0, 0, 0); __builtin_amdgcn_s_setprio(0); } while (0)
  #define G_WAIT_V(n) asm volatile("s_waitcnt vmcnt(" #n ")" ::: "memory")
  #define G_WAIT_L(n) asm volatile("s_waitcnt lgkmcnt(" #n ")" ::: "memory")
  #define G_BAR __builtin_amdgcn_s_barrier()
  #define G_SCHED __builtin_amdgcn_sched_barrier(0)
  const int ntm = ntiles / nct;
  auto unit = [&](int i, int& pm, int& pn) __attribute__((always_inline)) -> bool {
    const int Lg = i * G + blockIdx.x;
    if (Lg >= ntiles) return false;
    int wg = Lg;
    { const int q = ntiles >> 3, r = ntiles & 7, xcd = wg & 7, off = wg >> 3; wg = (xcd < r ? xcd * (q + 1) : r * (q + 1) + (xcd - r) * q) + off; }
    const int nig = 8 * nct, gid = wg / nig, fm = gid * 8, gsz = (ntm - fm) < 8 ? (ntm - fm) : 8;
    const int rem = wg - gid * nig;
    pm = fm + rem % gsz; pn = rem / gsz; return true;
  };
  int ui = 0, cpm, cpn, npm = 0, npn = 0;
  if (!unit(0, cpm, cpn)) return;
  f32x4 acc[2][2][4][2];
  #pragma unroll
  for (int a = 0; a < 2; ++a)
  #pragma unroll
    for (int b = 0; b < 2; ++b)
  #pragma unroll
      for (int m = 0; m < 4; ++m)
  #pragma unroll
        for (int n = 0; n < 2; ++n) acc[a][b][m][n] = (f32x4){0.f, 0.f, 0.f, 0.f};
  bf16x8 At[4][2], B0[2][2], B1[2][2];
  const char* cA = (const char*)Aact + (size_t)cpm * tstep; const char* cB = (const char*)Wt + (size_t)cpn * tstep;
  G_WAIT_V(0);
  G_STAGE(G_SB(0, 0), cB, voffB); G_STAGE(G_SA(0, 0), cA, voffA); G_STAGE(G_SB(0, 1), cB + hstep, voffB); G_STAGE(G_SA(0, 1), cA + hstep, voffA);
  if (wr == 1) G_BAR;
  G_WAIT_V(4); G_BAR;
  G_STAGE(G_SB(1, 0), cB + kstep, voffB); G_STAGE(G_SA(1, 0), cA + kstep, voffA); G_STAGE(G_SB(1, 1), cB + hstep + kstep, voffB);
  G_WAIT_V(6); G_BAR;
  for (;;) {
    bool has_next;
    has_next = unit(ui + 1, npm, npn);
    const char* nA = has_next ? (const char*)Aact + (size_t)npm * tstep : cA; const char* nB = has_next ? (const char*)Wt + (size_t)npn * tstep : cB;
    for (int t = 0; t < nt; t += 2) {
      const bool last = (t == nt - 2);
      const char* a1 = cA + (size_t)(t + 1) * kstep;
      const char* a2 = last ? nA : cA + (size_t)(t + 2) * kstep; const char* b2 = last ? nB : cB + (size_t)(t + 2) * kstep;
      const char* a3 = a2 + kstep; const char* b3 = b2 + kstep;
      G_LDB(B0, 0, 0); G_SCHED; G_LDA(At, 0, 0); G_STAGE(G_SA(1, 1), a1 + hstep, voffA);
      G_WAIT_L(8); G_BAR; G_WAIT_L(0); G_MMA(0, 0, At, B0); G_BAR; G_SCHED;
      G_LDB(B1, 0, 1); G_STAGE(G_SB(0, 0), b2, voffB);
      G_BAR; G_WAIT_L(0); G_MMA(0, 1, At, B1); G_BAR;
      G_LDA(At, 0, 1); G_STAGE(G_SA(0, 0), a2, voffA);
      G_BAR; G_WAIT_L(0); G_MMA(1, 0, At, B0); G_BAR; G_SCHED;
      G_STAGE(G_SB(0, 1), b2 + hstep, voffB);
      G_WAIT_V(6); G_BAR; G_MMA(1, 1, At, B1); G_BAR;
      G_LDB(B0, 1, 0); G_SCHED; G_LDA(At, 1, 0); G_STAGE(G_SA(0, 1), a2 + hstep, voffA);
      G_WAIT_L(8); G_BAR; G_WAIT_L(0); G_MMA(0, 0, At, B0); G_BAR; G_SCHED;
      G_LDB(B1, 1, 1); G_STAGE(G_SB(1, 0), b3, voffB);
      G_BAR; G_WAIT_L(0); G_MMA(0, 1, At, B1); G_BAR;
      G_LDA(At, 1, 1); G_STAGE(G_SA(1, 0), a3, voffA);
      G_BAR; G_WAIT_L(0); G_MMA(1, 0, At, B0); G_BAR; G_SCHED;
      G_STAGE(G_SB(1, 1), b3 + hstep, voffB);
      G_WAIT_V(6); G_BAR; G_MMA(1, 1, At, B1); G_BAR;
    }
    E(acc, cpm, cpn, wr, wc, fr, fq);
    if (!has_next) break;
    #pragma unroll
    for (int a = 0; a < 2; ++a)
    #pragma unroll
      for (int b = 0; b < 2; ++b)
    #pragma unroll
        for (int m = 0; m < 4; ++m)
    #pragma unroll
          for (int n = 0; n < 2; ++n) acc[a][b][m][n] = (f32x4){0.f, 0.f, 0.f, 0.f};
    cpm = npm; cpn = npn; cA = nA; cB = nB; ++ui;
  }
  G_WAIT_V(0);
  if (wr == 0) G_BAR;
  G_BAR;
  #undef G_SA
  #undef G_SB
  #undef G_STAGE
  #undef G_LDA
  #undef G_LDB
  #undef G_MMA
  #undef G_WAIT_V
  #undef G_WAIT_L
  #undef G_BAR
  #undef G_SCHED
}

DI void transpose_tiles(const Params& P, int tid, char* lds, int l, int first, int stride) {
  u16* winT = (u16*)(P.ws + WS_WIN) + (size_t)l * DP * D;
  u16* woutT = (u16*)(P.ws + WS_WOUT) + (size_t)l * D * D;
  float* tile = (float*)lds;
  for (int t2 = first; t2 < 960 + 256; t2 += stride) {
    const float* src; u16* dst; int N, kt, ntile, n_src;
    if (t2 < 960) { kt = t2 / 60; ntile = t2 % 60; N = DP; src = P.w_in + (size_t)l * D * DP; dst = winT; n_src = win_src_col(ntile * 64); }
    else { const int r2 = t2 - 960; kt = r2 >> 4; ntile = r2 & 15; N = D; src = P.w_out + (size_t)l * D * D; dst = woutT; n_src = ntile * 64; }
    const int k0 = kt * 64, n0 = ntile * 64;
    {
      const int r = tid >> 4, c4 = tid & 15;
      #pragma unroll
      for (int hh = 0; hh < 2; ++hh) {
        float4 v = *(const float4*)(src + (size_t)(k0 + r + hh * 32) * N + n_src + c4 * 4);
        float* tp = tile + (r + hh * 32) * 65 + c4 * 4;
        tp[0] = v.x; tp[1] = v.y; tp[2] = v.z; tp[3] = v.w;
      }
    }
    __syncthreads();
    {
      const int n = tid >> 3, kc = tid & 7;
      float f[8];
      #pragma unroll
      for (int e = 0; e < 8; ++e) f[e] = tile[(kc * 8 + e) * 65 + n];
      uint4 o; o.x = pk2(f[0], f[1]); o.y = pk2(f[2], f[3]); o.z = pk2(f[4], f[5]); o.w = pk2(f[6], f[7]);
      *(uint4*)(dst + (size_t)(n0 + n) * D + k0 + kc * 8) = o;
    }
    __syncthreads();
  }
}

DI void phase0(const Params& P, int wv, char* lds) {
  const int tid = opaque_tid(wv);
  float* mod = (float*)(P.ws + WS_MOD);
  constexpr int NG = 192;
  for (int task = blockIdx.x; task < NG; task += gridDim.x) {
    const int l = task / 48, rem = task % 48, nc = rem >> 3, ks = rem & 7;
    float* s = (float*)lds;
    for (int id = tid; id < 17 * 128; id += 512) {
      int r = id >> 7, kk = id & 127;
      float v = (r < 16) ? P.c[r * D + ks * 128 + kk] : P.c_ctx[ks * 128 + kk];
      s[id] = silu_f(v);
    }
    __syncthreads();
    const int n = nc * 512 + tid;
    float acc[17];
    #pragma unroll
    for (int r = 0; r < 17; ++r) acc[r] = 0.f;
    const float* wp = P.w_ada + ((size_t)l * D + ks * 128) * 3072 + n;
    for (int k4 = 0; k4 < 32; ++k4) {
      float w0 = wp[(size_t)(k4 * 4 + 0) * 3072], w1 = wp[(size_t)(k4 * 4 + 1) * 3072];
      float w2 = wp[(size_t)(k4 * 4 + 2) * 3072], w3 = wp[(size_t)(k4 * 4 + 3) * 3072];
      #pragma unroll
      for (int r = 0; r < 17; ++r) {
        float4 sv = *(const float4*)(s + r * 128 + k4 * 4);
        acc[r] += sv.x * w0 + sv.y * w1 + sv.z * w2 + sv.w * w3;
      }
    }
    const float bias = (ks == 0) ? P.b_ada[l * 3072 + n] : 0.f;
    #pragma unroll
    for (int r = 0; r < 17; ++r) atomicAdd(mod + ((size_t)l * 17 + r) * 3072 + n, acc[r] + bias);
    __syncthreads();
  }
  transpose_tiles(P, tid, lds, 0, (blockIdx.x + gridDim.x - NG % gridDim.x) % gridDim.x, gridDim.x);
}

DI void phase_resnorm(const Params& P, int wv, int l) {
  const int tid = opaque_tid(wv), lane = tid & 63;
  const float* modl = (const float*)(P.ws + WS_MOD) + (size_t)(l < DEPTH ? l : 0) * 17 * 3072;
  const float* modp = (const float*)(P.ws + WS_MOD) + (size_t)(l > 0 ? l - 1 : 0) * 17 * 3072;
  float* ctxs = (float*)(P.ws + WS_CTX);
  u16* h = (u16*)(P.ws + WS_HM);
  const u16* y = (const u16*)(P.ws + WS_Y);
  const bool fin = (l == DEPTH);
  const float* g = fin ? P.final_g : P.norm_g + l * D;
  const int nrows = fin ? ML : MT;
  const int nw = gridDim.x * 8;
  float4 gg[4];
  #pragma unroll
  for (int i = 0; i < 4; ++i) gg[i] = *(const float4*)(g + (i * 64 + lane) * 4);
  for (int row0 = blockIdx.x * 8 + wv; row0 < nrows; row0 += 2 * nw) {
    float4 v[2][4], gt[2][4], sh[2][4], sc[2][4];
    uint2 yv[2][4];
    float* dst[2]; bool ok[2];
    #pragma unroll
    for (int k = 0; k < 2; ++k) {
      const int row = row0 + k * nw;
      ok[k] = row < nrows;
      const int rw = ok[k] ? row : row0;
      const float* src; int rr;
      if (rw < ML) { src = (l <= 1 ? P.x : P.out) + (size_t)rw * D; dst[k] = P.out + (size_t)rw * D; rr = rw >> 12; }
      else { src = (l <= 1 ? P.ctx : ctxs) + (size_t)(rw - ML) * D; dst[k] = ctxs + (size_t)(rw - ML) * D; rr = 16; }
      #pragma unroll
      for (int i = 0; i < 4; ++i) { const f32x4 t = __builtin_nontemporal_load((const f32x4*)(src + (i * 64 + lane) * 4)); v[k][i] = make_float4(t[0], t[1], t[2], t[3]); }
      if (l > 0) {
        #pragma unroll
        for (int i = 0; i < 4; ++i) {
          { const u32x2 t = __builtin_nontemporal_load((const u32x2*)(y + (size_t)rw * D + (i * 64 + lane) * 4)); yv[k][i] = make_uint2(t[0], t[1]); }
          gt[k][i] = *(const float4*)(modp + rr * 3072 + 2048 + (i * 64 + lane) * 4);
        }
      }
      if (!fin) {
        #pragma unroll
        for (int i = 0; i < 4; ++i) {
          sh[k][i] = *(const float4*)(modl + rr * 3072 + (i * 64 + lane) * 4);
          sc[k][i] = *(const float4*)(modl + rr * 3072 + 1024 + (i * 64 + lane) * 4);
        }
      }
    }
    __builtin_amdgcn_sched_barrier(0);
    #pragma unroll
    for (int k = 0; k < 2; ++k) {
      if (!ok[k]) continue;
      const int row = row0 + k * nw;
      float ss = 0.f;
      if (l > 0) {
        #pragma unroll
        for (int i = 0; i < 4; ++i) {
          v[k][i].x += gt[k][i].x * bflo(yv[k][i].x); v[k][i].y += gt[k][i].y * bfhi(yv[k][i].x);
          v[k][i].z += gt[k][i].z * bflo(yv[k][i].y); v[k][i].w += gt[k][i].w * bfhi(yv[k][i].y);
          if (!fin) { f32x4 t; t[0] = v[k][i].x; t[1] = v[k][i].y; t[2] = v[k][i].z; t[3] = v[k][i].w; __builtin_nontemporal_store(t, (f32x4*)(dst[k] + (i * 64 + lane) * 4)); }
        }
      }
      #pragma unroll
      for (int i = 0; i < 4; ++i) ss += v[k][i].x * v[k][i].x + v[k][i].y * v[k][i].y + v[k][i].z * v[k][i].z + v[k][i].w * v[k][i].w;
      ss = wave_sum(ss);
      const float rstd = rsqrtf(ss * (1.f / D) + 1e-6f);
      if (fin) {
        #pragma unroll
        for (int i = 0; i < 4; ++i) {
          const int c = (i * 64 + lane) * 4;
          float4 o; o.x = v[k][i].x * rstd * gg[i].x; o.y = v[k][i].y * rstd * gg[i].y; o.z = v[k][i].z * rstd * gg[i].z; o.w = v[k][i].w * rstd * gg[i].w;
          *(float4*)(dst[k] + c) = o;
        }
      } else {
        #pragma unroll
        for (int i = 0; i < 4; ++i) {
          const int c = (i * 64 + lane) * 4;
          const float a0 = v[k][i].x * rstd * gg[i].x * (1.f + sc[k][i].x) + sh[k][i].x;
          const float a1 = v[k][i].y * rstd * gg[i].y * (1.f + sc[k][i].y) + sh[k][i].y;
          const float a2 = v[k][i].z * rstd * gg[i].z * (1.f + sc[k][i].z) + sh[k][i].z;
          const float a3 = v[k][i].w * rstd * gg[i].w * (1.f + sc[k][i].w) + sh[k][i].w;
          uint2 o; o.x = pk2(a0, a1); o.y = pk2(a2, a3);
          *(uint2*)(h + (size_t)row * D + c) = o;
        }
      }
    }
  }
}

DI void phase_inproj(const Params& P, int wv, int l, char* lds) {
  const u16* W = (const u16*)(P.ws + WS_WIN) + (size_t)l * DP * D;
  const u16* h = (const u16*)(P.ws + WS_HM);
  u16* z = (u16*)(P.ws + WS_Z);
  constexpr int NCT = DP / 256;
  gemm_phase<true>(P, wv, h, W, NTT * NCT, NCT, (LAS unsigned char*)lds,
    [&](const f32x4 (&acc)[2][2][4][2], int pm, int pn, int wr, int wc, int fr, int fq) __attribute__((always_inline)) {
      const int row0 = pm * BM + wr * 64 + fr, cw = wc * 32 + 8 * fq;
      if (pn >= 4 && pn < 10) {
        u16* zp = z + Z_Q + (pn - 4) * 256 + cw;
        #pragma unroll
        for (int ai = 0; ai < 2; ++ai)
        #pragma unroll
          for (int m = 0; m < 4; ++m) {
            u16* rowp = zp + (size_t)(row0 + ai * HALF + m * 16) * ZC;
            #pragma unroll
            for (int bj = 0; bj < 2; ++bj) {
              const f32x4 v0 = acc[ai][bj][m][0], v1 = acc[ai][bj][m][1];
              uint4 o; o.x = pk2(v0[0], v0[1]); o.y = pk2(v0[2], v0[3]); o.z = pk2(v1[0], v1[1]); o.w = pk2(v1[2], v1[3]);
              if (pn < 6) st16_nt(rowp + bj * HALF, o); else *(uint4*)(rowp + bj * HALF) = o;
            }
          }
      } else if (pn == 10 || pn == 11 || pn == 14) {
        u16* zp = z + (pn == 14 ? Z_CFG : Z_NG + (pn - 10) * 256) + cw;
        #pragma unroll
        for (int ai = 0; ai < 2; ++ai)
        #pragma unroll
          for (int m = 0; m < 4; ++m) {
            u16* rowp = zp + (size_t)(row0 + ai * HALF + m * 16) * ZC;
            #pragma unroll
            for (int bj = 0; bj < 2; ++bj) {
              const f32x4 v0 = acc[ai][bj][m][0], v1 = acc[ai][bj][m][1];
              uint4 o; o.x = pk2(silu_f(v0[0]), silu_f(v0[1])); o.y = pk2(silu_f(v0[2]), silu_f(v0[3]));
              o.z = pk2(silu_f(v1[0]), silu_f(v1[1])); o.w = pk2(silu_f(v1[2]), silu_f(v1[3]));
              st16_nt(rowp + bj * HALF, o);
            }
          }
      } else {
        const int mode = (pn < 2) ? 0 : (pn < 4 ? 1 : 2);
        const int ob = (pn < 2) ? Z_SCV + pn * 128 : (pn < 4 ? Z_SCG + (pn - 2) * 128 : Z_CFU + (pn - 12) * 128);
        u16* zp = z + ob + cw;
        #pragma unroll
        for (int ai = 0; ai < 2; ++ai)
        #pragma unroll
          for (int m = 0; m < 4; ++m) {
            float o8[8];
            #pragma unroll
            for (int n = 0; n < 2; ++n)
            #pragma unroll
              for (int j = 0; j < 4; ++j) {
                const float a = acc[ai][0][m][n][j], b = acc[ai][1][m][n][j];
                o8[n * 4 + j] = a * (mode == 0 ? b : (mode == 1 ? silu_f(b) : sigmoid_f(b)));
              }
            uint4 o; o.x = pk2(o8[0], o8[1]); o.y = pk2(o8[2], o8[3]); o.z = pk2(o8[4], o8[5]); o.w = pk2(o8[6], o8[7]);
            st16_nt(zp + (size_t)(row0 + ai * HALF + m * 16) * ZC, o);
          }
      }
    });
}

DI void phase_outproj(const Params& P, int wv, int l, char* lds) {
  const u16* W = (const u16*)(P.ws + WS_WOUT) + (size_t)l * D * D;
  const u16* mm = (const u16*)(P.ws + WS_HM);
  u16* y = (u16*)(P.ws + WS_Y);
  const int ntt = (l == DEPTH - 1) ? (ML / 256) : NTT;
  gemm_phase<true>(P, wv, mm, W, ntt * 4, 4, (LAS unsigned char*)lds,
    [&](const f32x4 (&acc)[2][2][4][2], int pm, int pn, int wr, int wc, int fr, int fq) __attribute__((always_inline)) {
      const int row0 = pm * BM + wr * 64 + fr, col0 = pn * BM + wc * 32 + 8 * fq;
      #pragma unroll
      for (int ai = 0; ai < 2; ++ai)
      #pragma unroll
        for (int m = 0; m < 4; ++m) {
          u16* rowp = y + (size_t)(row0 + ai * HALF + m * 16) * D + col0;
          #pragma unroll
          for (int bj = 0; bj < 2; ++bj) {
            const f32x4 v0 = acc[ai][bj][m][0], v1 = acc[ai][bj][m][1];
            uint4 o; o.x = pk2(v0[0], v0[1]); o.y = pk2(v0[2], v0[3]); o.z = pk2(v1[0], v1[1]); o.w = pk2(v1[2], v1[3]);
            *(uint4*)(rowp + bj * HALF) = o;
          }
        }
    });
  if (l + 1 < DEPTH) {
    const int busy = ntt * 4 - 4 * (int)gridDim.x;
    if (busy > 0 && busy < (int)gridDim.x && (int)blockIdx.x >= busy)
      transpose_tiles(P, opaque_tid(wv), lds, l + 1, (int)blockIdx.x - busy, (int)gridDim.x - busy);
    else if (busy <= 0 || busy >= (int)gridDim.x)
      transpose_tiles(P, opaque_tid(wv), lds, l + 1, (int)blockIdx.x, (int)gridDim.x);
  }
}

constexpr int BIAS_OFF = 832 * 128;
struct AttnTask { int b, h, r0, half, lat; };
DI AttnTask attn_decode(int task) {
  AttnTask t; t.lat = (task < 4096) ? 1 : 0; t.r0 = 0; t.half = 0;
  if (t.lat) { t.b = task >> 8; t.h = (task >> 5) & 7; t.r0 = (task & 31) * 2; }
  else { const int t2 = task - 4096; t.b = t2 >> 4; t.h = (t2 >> 1) & 7; t.half = t2 & 1; }
  return t;
}

DI void attn_loop(const Params& P, int wv, int l, int n_attn, char* lds_g, int r_begin, int r_end) {
  LAS char* lds = (LAS char*)lds_g;
  const u16* z = (const u16*)(P.ws + WS_Z);
  u16* mb = (u16*)(P.ws + WS_HM);
  const int tid = opaque_tid(wv);
  const int G = gridDim.x;
  int task = logical_block() + r_begin * G, round = r_begin;
  if (task >= n_attn || r_begin >= r_end) return;

  int lane, fr, fq, w, st_lds, kl0, kl1, tl[4];
  const u16* zl;
  auto lane_consts = [&](int tq) __attribute__((always_inline)) {
    lane = tq & 63; fr = lane & 15; fq = lane >> 4;
    w = __builtin_amdgcn_readfirstlane(tq >> 6);
    const int st_row = tq >> 3, st_c = tq & 7;
    st_lds = st_row * 128 + ((st_c ^ (((st_row >> 1) & 3) << 1) ^ ((st_row >> 3) & 1)) << 4);
    zl = z + (size_t)st_row * ZC + st_c * 8;
    const int ksw = (((fr >> 1) & 3) << 1) ^ (fr >> 3);
    kl0 = fr * 128 + ((fq ^ ksw) << 4);
    kl1 = fr * 128 + (((fq + 4) ^ ksw) << 4);
    const int q4 = fr >> 2, p4 = fr & 3, trow = 4 * fq + q4, tsw = (((trow >> 1) & 3) << 1) ^ (fq >> 1);
    #pragma unroll
    for (int mbk = 0; mbk < 4; ++mbk) tl[mbk] = trow * 128 + (((2 * mbk + (p4 >> 1)) ^ tsw) << 4) + 8 * (p4 & 1);
  };
  lane_consts(tid);
  typedef LAS s16x4* lds_s16x4_p;
  constexpr float LOG2E = 1.4426950408889634f;
  constexpr float SC2 = 0.125f * LOG2E;

  u32x4 rg[13];
  float brg[2];
  auto load_img = [&](const AttnTask& t, int coloff) __attribute__((always_inline)) {
    const size_t ctxbase = (size_t)ML + t.b * NCTX;
    const int rs0 = clampi(t.r0 - 4, 0, 56);
    #pragma unroll
    for (int i = 0; i < 4; ++i) rg[9 + i] = *(const u32x4*)(zl + (ctxbase + i * 64) * ZC + coloff);
    if (t.lat) {
      #pragma unroll
      for (int i = 0; i < 9; ++i) {
        const int gr = min(rs0 + i, 63);
        rg[i] = *(const u32x4*)(zl + ((size_t)t.b * SEQ + gr * 64) * ZC + coloff);
      }
    }
  };
  auto store_img = [&](const AttnTask& t) __attribute__((always_inline)) {
    if (t.lat) {
      #pragma unroll
      for (int i = 0; i < 9; ++i) *(LAS u32x4*)(lds + st_lds + i * 8192) = rg[i];
    }
    #pragma unroll
    for (int i = 0; i < 4; ++i) *(LAS u32x4*)(lds + st_lds + (9 + i) * 8192) = rg[9 + i];
  };
  auto load_bias = [&](const AttnTask& t) __attribute__((always_inline)) {
    if (t.lat) {
      #pragma unroll
      for (int j = 0; j < 2; ++j) {
        const int id = tid + j * 512, ri = id >> 6, ci = (id & 63) - 16;
        brg[j] = (id < 960 && ci >= 0 && ci < 31) ? P.rpb[((size_t)l * 8 + t.h) * 465 + ri * 31 + ci] * LOG2E : 0.f;
      }
    }
  };

  AttnTask cur = attn_decode(task);
  load_img(cur, Z_K + cur.h * 64);
  load_bias(cur);
  if (wv >= 4) __builtin_amdgcn_s_setprio(1);
  for (;;) {
    { int tq = tid; asm volatile("" : "+v"(tq)); lane_consts(tq); }
    store_img(cur);
    if (cur.lat) {
      ((LAS float*)(lds + BIAS_OFF))[tid] = brg[0];
      if (tid < 960 - 512) ((LAS float*)(lds + BIAS_OFF))[tid + 512] = brg[1];
    }
    load_img(cur, Z_V + cur.h * 64);
    const int b = cur.b, h = cur.h;
    const size_t ctxbase = (size_t)ML + b * NCTX;
    const int rs0 = clampi(cur.r0 - 4, 0, 56);
    int r = 0, c0 = 0, rs = 0, rowoff = 0, cb = 0;
    size_t qtok;
    if (cur.lat) {
      r = cur.r0 + (w >> 2); c0 = 16 * (w & 3); rs = clampi(r - 4, 0, 56); rowoff = rs - rs0; cb = clampi(c0 - 8, 0, 32);
      qtok = (size_t)b * SEQ + r * 64 + c0 + fr;
    } else {
      qtok = ctxbase + cur.half * 128 + w * 16 + fr;
    }
    const int wb = (rowoff * 64 + cb) * 128;
    const int pbx = ((cb >> 3) & 1) << 4;
    const bf16x8 qf0 = *(const bf16x8*)(z + qtok * ZC + Z_Q + h * 64 + fq * 8);
    const bf16x8 qf1 = *(const bf16x8*)(z + qtok * ZC + Z_Q + h * 64 + 32 + fq * 8);
    __syncthreads();

    bf16x8 pc[8], pw[8];
    float mc, lc = 0.f, mw = -1e30f, lw = 0.f;
    {
      f32x4 sc[16];
      float mxc = -1e30f;
      bf16x8 fa[4], fb[4];
      #pragma unroll
      for (int u = 0; u < 2; ++u) {
        fa[2 * u]     = *(const LAS bf16x8*)(lds + 73728 + kl0 + u * 2048);
        fa[2 * u + 1] = *(const LAS bf16x8*)(lds + 73728 + kl1 + u * 2048);
      }
      #pragma unroll
      for (int g = 0; g < 8; ++g) {
        if (g + 1 < 8) {
          #pragma unroll
          for (int u = 0; u < 2; ++u) {
            const bf16x8 x0 = *(const LAS bf16x8*)(lds + 73728 + kl0 + (2 * g + 2 + u) * 2048);
            const bf16x8 x1 = *(const LAS bf16x8*)(lds + 73728 + kl1 + (2 * g + 2 + u) * 2048);
            if (g & 1) { fa[2 * u] = x0; fa[2 * u + 1] = x1; } else { fb[2 * u] = x0; fb[2 * u + 1] = x1; }
          }
        }
        __builtin_amdgcn_sched_barrier(0);
        #pragma unroll
        for (int u = 0; u < 2; ++u) {
          const bf16x8 k0 = (g & 1) ? fb[2 * u] : fa[2 * u];
          const bf16x8 k1 = (g & 1) ? fb[2 * u + 1] : fa[2 * u + 1];
          f32x4 a = {0.f, 0.f, 0.f, 0.f};
          a = __builtin_amdgcn_mfma_f32_16x16x32_bf16(k0, qf0, a, 0, 0, 0);
          a = __builtin_amdgcn_mfma_f32_16x16x32_bf16(k1, qf1, a, 0, 0, 0);
          #pragma unroll
          for (int i = 0; i < 4; ++i) mxc = fmaxf(mxc, a[i]);
          sc[2 * g + u] = a;
        }
        __builtin_amdgcn_sched_barrier(0);
      }
      mxc = fmaxf(mxc, __shfl_xor(mxc, 16));
      mxc = fmaxf(mxc, __shfl_xor(mxc, 32));
      mc = mxc * SC2;
      #pragma unroll
      for (int jj = 0; jj < 8; ++jj) {
        float e[8];
        #pragma unroll
        for (int i = 0; i < 4; ++i) { e[i] = fexp2(sc[2 * jj][i] * SC2 - mc); e[4 + i] = fexp2(sc[2 * jj + 1][i] * SC2 - mc); }
        #pragma unroll
        for (int i = 0; i < 8; ++i) lc += e[i];
        u32x4 bu; bu[0] = pk2(e[0], e[1]); bu[1] = pk2(e[2], e[3]); bu[2] = pk2(e[4], e[5]); bu[3] = pk2(e[6], e[7]);
        pc[jj] = __builtin_bit_cast(bf16x8, bu);
      }
    }
    if (cur.lat) {
      const int qc = c0 + fr, cs = clampi(qc - 8, 0, 48);
      bool vm[4];
      int boff[4];
      const int bci = cb - c0 + 15 + 4 * fq - fr + 16;
      #pragma unroll
      for (int i = 0; i < 4; ++i) { const int kc = cb + 4 * fq + i; vm[i] = (kc >= cs) && (kc < cs + 16); boff[i] = bci + i + (vm[i] ? 0 : 16); }
      const LAS float* bl = (const LAS float*)(lds + BIAS_OFF) + (rs - r + 7) * 64;
      const int wk0 = wb + (kl0 ^ pbx), wk1 = wb + (kl1 ^ pbx);
      f32x4 sw[8];
      float mxw = -1e30f;
      bf16x8 fa[4], fb[4];
      float ba[4], bb[4];
      fa[0] = *(const LAS bf16x8*)(lds + wk0); fa[1] = *(const LAS bf16x8*)(lds + wk1);
      fa[2] = *(const LAS bf16x8*)(lds + wk0 + 2048); fa[3] = *(const LAS bf16x8*)(lds + wk1 + 2048);
      #pragma unroll
      for (int i = 0; i < 4; ++i) ba[i] = bl[boff[i]];
      #pragma unroll
      for (int jj = 0; jj < 8; ++jj) {
        if (jj + 1 < 8) {
          const bf16x8 x0 = *(const LAS bf16x8*)(lds + wk0 + (jj + 1) * 8192), x1 = *(const LAS bf16x8*)(lds + wk1 + (jj + 1) * 8192);
          const bf16x8 x2 = *(const LAS bf16x8*)(lds + wk0 + (jj + 1) * 8192 + 2048), x3 = *(const LAS bf16x8*)(lds + wk1 + (jj + 1) * 8192 + 2048);
          if (jj & 1) { fa[0] = x0; fa[1] = x1; fa[2] = x2; fa[3] = x3; } else { fb[0] = x0; fb[1] = x1; fb[2] = x2; fb[3] = x3; }
          #pragma unroll
          for (int i = 0; i < 4; ++i) { const float t = bl[(jj + 1) * 64 + boff[i]]; if (jj & 1) ba[i] = t; else bb[i] = t; }
        }
        __builtin_amdgcn_sched_barrier(0);
        f32x4 a0 = {0.f, 0.f, 0.f, 0.f}, a1 = {0.f, 0.f, 0.f, 0.f};
        a0 = __builtin_amdgcn_mfma_f32_16x16x32_bf16((jj & 1) ? fb[0] : fa[0], qf0, a0, 0, 0, 0);
        a0 = __builtin_amdgcn_mfma_f32_16x16x32_bf16((jj & 1) ? fb[1] : fa[1], qf1, a0, 0, 0, 0);
        a1 = __builtin_amdgcn_mfma_f32_16x16x32_bf16((jj & 1) ? fb[2] : fa[2], qf0, a1, 0, 0, 0);
        a1 = __builtin_amdgcn_mfma_f32_16x16x32_bf16((jj & 1) ? fb[3] : fa[3], qf1, a1, 0, 0, 0);
        f32x4 a;
        #pragma unroll
        for (int i = 0; i < 4; ++i) {
          const float bias = (jj & 1) ? bb[i] : ba[i];
          a[i] = (vm[i] ? a0[i] : a1[i]) * SC2 + bias;
          mxw = fmaxf(mxw, a[i]);
        }
        sw[jj] = a;
        __builtin_amdgcn_sched_barrier(0);
      }
      mxw = fmaxf(mxw, __shfl_xor(mxw, 16));
      mxw = fmaxf(mxw, __shfl_xor(mxw, 32));
      mw = mxw;
      #pragma unroll
      for (int jj = 0; jj < 8; ++jj) {
        float e0[4], e1[4];
        #pragma unroll
        for (int i = 0; i < 4; ++i) {
          const float e = fexp2(sw[jj][i] - mw);
          lw += e;
          e0[i] = vm[i] ? e : 0.f; e1[i] = vm[i] ? 0.f : e;
        }
        u32x4 bu; bu[0] = pk2(e0[0], e0[1]); bu[1] = pk2(e0[2], e0[3]); bu[2] = pk2(e1[0], e1[1]); bu[3] = pk2(e1[2], e1[3]);
        pw[jj] = __builtin_bit_cast(bf16x8, bu);
      }
    } else {
      #pragma unroll
      for (int jj = 0; jj < 8; ++jj) pw[jj] = (bf16x8){0, 0, 0, 0, 0, 0, 0, 0};
    }
    lc += __shfl_xor(lc, 16); lc += __shfl_xor(lc, 32);
    lw += __shfl_xor(lw, 16); lw += __shfl_xor(lw, 32);
    const float mfin = fmaxf(mc, mw);
    const float fc = fexp2(mc - mfin), fw = fexp2(mw - mfin);
    const float inv = __builtin_amdgcn_rcpf(lc * fc + lw * fw);
    const float gc = fc * inv, gw = fw * inv;

    __syncthreads();
    store_img(cur);
    const int ntask = task + G;
    const bool has_next = (ntask < n_attn) && (round + 1 < r_end);
    AttnTask nxt = cur;
    if (has_next) { nxt = attn_decode(ntask); load_img(nxt, Z_K + nxt.h * 64); load_bias(nxt); }
    __syncthreads();

    uint2 gv[4];
    #pragma unroll
    for (int mbk = 0; mbk < 4; ++mbk) gv[mbk] = ld8_nt(z + qtok * ZC + Z_NG + h * 64 + 16 * mbk + 4 * fq);
    f32x4 oc[4], ow[4];
    #pragma unroll
    for (int mbk = 0; mbk < 4; ++mbk) { f32x4 zz = {0.f, 0.f, 0.f, 0.f}; oc[mbk] = zz; ow[mbk] = zz; }
    {
      s16x4 r3[3][8];
      #pragma unroll
      for (int p = 0; p < 2; ++p)
      #pragma unroll
        for (int mbk = 0; mbk < 4; ++mbk) {
          r3[p][2 * mbk]     = __builtin_amdgcn_ds_read_tr16_b64_v4i16((lds_s16x4_p)(lds + 73728 + tl[mbk] + p * 4096));
          r3[p][2 * mbk + 1] = __builtin_amdgcn_ds_read_tr16_b64_v4i16((lds_s16x4_p)(lds + 73728 + tl[mbk] + p * 4096 + 2048));
        }
      #pragma unroll
      for (int jj = 0; jj < 8; ++jj) {
        if (jj + 2 < 8) {
          #pragma unroll
          for (int mbk = 0; mbk < 4; ++mbk) {
            r3[(jj + 2) % 3][2 * mbk]     = __builtin_amdgcn_ds_read_tr16_b64_v4i16((lds_s16x4_p)(lds + 73728 + tl[mbk] + (jj + 2) * 4096));
            r3[(jj + 2) % 3][2 * mbk + 1] = __builtin_amdgcn_ds_read_tr16_b64_v4i16((lds_s16x4_p)(lds + 73728 + tl[mbk] + (jj + 2) * 4096 + 2048));
          }
        }
        __builtin_amdgcn_sched_barrier(0);
        #pragma unroll
        for (int mbk = 0; mbk < 4; ++mbk) {
          const bf16x8 av = __builtin_shufflevector(r3[jj % 3][2 * mbk], r3[jj % 3][2 * mbk + 1], 0, 1, 2, 3, 4, 5, 6, 7);
          oc[mbk] = __builtin_amdgcn_mfma_f32_16x16x32_bf16(av, pc[jj], oc[mbk], 0, 0, 0);
        }
        __builtin_amdgcn_sched_barrier(0);
      }
    }
    if (cur.lat) {
      s16x4 r3[3][8];
      const int tw = wb;
      #pragma unroll
      for (int p = 0; p < 2; ++p)
      #pragma unroll
        for (int mbk = 0; mbk < 4; ++mbk) {
          const int ta = tw + (tl[mbk] ^ pbx) + p * 8192;
          r3[p][2 * mbk]     = __builtin_amdgcn_ds_read_tr16_b64_v4i16((lds_s16x4_p)(lds + ta));
          r3[p][2 * mbk + 1] = __builtin_amdgcn_ds_read_tr16_b64_v4i16((lds_s16x4_p)(lds + ta + 2048));
        }
      #pragma unroll
      for (int jj = 0; jj < 8; ++jj) {
        if (jj + 2 < 8) {
          #pragma unroll
          for (int mbk = 0; mbk < 4; ++mbk) {
            const int ta = tw + (tl[mbk] ^ pbx) + (jj + 2) * 8192;
            r3[(jj + 2) % 3][2 * mbk]     = __builtin_amdgcn_ds_read_tr16_b64_v4i16((lds_s16x4_p)(lds + ta));
            r3[(jj + 2) % 3][2 * mbk + 1] = __builtin_amdgcn_ds_read_tr16_b64_v4i16((lds_s16x4_p)(lds + ta + 2048));
          }
        }
        __builtin_amdgcn_sched_barrier(0);
        #pragma unroll
        for (int mbk = 0; mbk < 4; ++mbk) {
          const bf16x8 av = __builtin_shufflevector(r3[jj % 3][2 * mbk], r3[jj % 3][2 * mbk + 1], 0, 1, 2, 3, 4, 5, 6, 7);
          ow[mbk] = __builtin_amdgcn_mfma_f32_16x16x32_bf16(av, pw[jj], ow[mbk], 0, 0, 0);
        }
        __builtin_amdgcn_sched_barrier(0);
      }
    }
    #pragma unroll
    for (int mbk = 0; mbk < 4; ++mbk) {
      const int dh = 16 * mbk + 4 * fq;
      const float g0 = bflo(gv[mbk].x), g1 = bfhi(gv[mbk].x), g2 = bflo(gv[mbk].y), g3 = bfhi(gv[mbk].y);
      const float o0 = oc[mbk][0] * gc + ow[mbk][0] * gw, o1 = oc[mbk][1] * gc + ow[mbk][1] * gw;
      const float o2 = oc[mbk][2] * gc + ow[mbk][2] * gw, o3 = oc[mbk][3] * gc + ow[mbk][3] * gw;
      uint2 ov; ov.x = pk2(o0 * g0, o1 * g1); ov.y = pk2(o2 * g2, o3 * g3);
      *(uint2*)(mb + qtok * D + 256 + h * 64 + dh) = ov;
    }
    __syncthreads();
    if (!has_next) break;
    cur = nxt; task = ntask; ++round;
  }
  __builtin_amdgcn_s_setprio(0);
}

struct ConvTask { int L, t0; size_t tokbase; };
DI ConvTask conv_decode(int task) {
  ConvTask t;
  if (task < 1024) { const int b = task >> 6; t.t0 = (task & 63) * 64; t.L = SEQ; t.tokbase = (size_t)b * SEQ; }
  else { const int t2 = task - 1024; const int b = t2 >> 2; t.t0 = (t2 & 3) * 64; t.L = NCTX; t.tokbase = (size_t)ML + b * NCTX; }
  return t;
}

DI void conv_loop(const Params& P, int wv, int l, int n_conv, int first, char* lds, int max_iters) {
  const u16* z = (const u16*)(P.ws + WS_Z);
  u16* mb = (u16*)(P.ws + WS_HM);
  const int tid = opaque_tid(wv);
  const int G = gridDim.x;
  int task = first, iters = 1;
  if (task >= n_conv) return;
  u16* U = (u16*)lds;
  float* O = (float*)(lds + 49152);

  uint4 pv[6];
  auto load_pq = [&](const ConvTask& t, int tq_) __attribute__((always_inline)) {
    #pragma unroll
    for (int it = 0; it < 6; ++it) {
      const int id = tq_ + it * 512, trow = id >> 5, cgA = id & 31;
      const int tt = t.t0 - 15 + trow;
      const bool ok = (id < 94 * 32) && tt >= 0 && tt < t.L;
      const u16* zr = z + (t.tokbase + (ok ? tt : t.t0)) * ZC;
      pv[it] = ld16_nt(zr + Z_CFU + cgA * 8);
    }
  };
  ConvTask cur = conv_decode(task);
  load_pq(cur, tid);

  for (;;) {
    const int L = cur.L, t0 = cur.t0; const size_t tokbase = cur.tokbase;
    int lq = l, tq = tid;
    asm volatile("" : "+s"(lq), "+v"(tq));
    const int c = tq & 255, run = tq >> 8;
    const int cg8 = tq & 31, srun = tq >> 5;
    const int lane = tq & 63, w = tq >> 6;
    #pragma unroll
    for (int it = 0; it < 6; ++it) {
      const int id = tq + it * 512, trow = id >> 5, cgA = id & 31;
      const int tt = t0 - 15 + trow;
      const bool ok = tt >= 0 && tt < L;
      if (id < 94 * 32) {
        uint4 o = pv[it];
        if (!ok) o = make_uint4(0u, 0u, 0u, 0u);
        *(uint4*)(U + trow * 256 + cgA * 8) = o;
      }
    }
    {
    uint4 hv[6], bv[4];
    #pragma unroll
    for (int jj = 0; jj < 6; ++jj) {
      const int tt = t0 + srun * 4 - 1 + jj;
      const bool ok = tt >= 0 && tt < L;
      const u16* zr = z + (tokbase + (ok ? tt : t0)) * ZC;
      hv[jj] = ld16_nt(zr + Z_SCV + cg8 * 8);
    }
    #pragma unroll
    for (int i = 0; i < 4; ++i) {
      const u16* zr = z + (tokbase + t0 + srun * 4 + i) * ZC;
      bv[i] = ld16_nt(zr + Z_SCG + cg8 * 8);
    }
      const float* wsc = P.conv_sc + (size_t)lq * 3 * 256 + cg8 * 8;
      float w0[8], w1[8], w2[8];
      #pragma unroll
      for (int e = 0; e < 8; ++e) { w0[e] = wsc[e]; w1[e] = wsc[256 + e]; w2[e] = wsc[512 + e]; }
      float v[6][8];
      #pragma unroll
      for (int jj = 0; jj < 6; ++jj) {
        const int tt = t0 + srun * 4 - 1 + jj;
        const bool ok = tt >= 0 && tt < L;
        float hf[8]; unpack8(hv[jj], hf);
        #pragma unroll
        for (int e = 0; e < 8; ++e) v[jj][e] = ok ? hf[e] : 0.f;
      }
      #pragma unroll
      for (int i = 0; i < 4; ++i) {
        const size_t tok = tokbase + t0 + srun * 4 + i;
        float bf[8], of[8]; unpack8(bv[i], bf);
        #pragma unroll
        for (int e = 0; e < 8; ++e)
          of[e] = bf[e] * (w0[e] * v[i][e] + w1[e] * v[i + 1][e] + w2[e] * v[i + 2][e]);
        uint4 ov; ov.x = pk2(of[0], of[1]); ov.y = pk2(of[2], of[3]); ov.z = pk2(of[4], of[5]); ov.w = pk2(of[6], of[7]);
        *(uint4*)(mb + tok * D + cg8 * 8) = ov;
      }
    }

    __syncthreads();

    const int ntask = task + G;
    const bool has_next = (ntask < n_conv) && (iters < max_iters);
    ConvTask nxt = cur;
    if (has_next) { nxt = conv_decode(ntask); load_pq(nxt, tq); }

    {
      const float* wcf = P.conv_cf + (size_t)lq * 31 * 256 + c;
      float wk[31];
      #pragma unroll
      for (int k = 0; k < 31; ++k) wk[k] = wcf[k * 256];
      f32x2 W2[32];
      #pragma unroll
      for (int k = 0; k < 32; ++k) { W2[k][0] = (k < 31) ? wk[k] : 0.f; W2[k][1] = (k > 0) ? wk[k - 1] : 0.f; }
      const float bias = P.conv_cf_b[lq * 256 + c];
      #pragma unroll 1
      for (int ob = 0; ob < 4; ++ob) {
        const int r0 = run * 32 + ob * 8;
        const u16* up = U + r0 * 256 + c;
        f32x2 acc2[4];
        #pragma unroll
        for (int p = 0; p < 4; ++p) { acc2[p][0] = bias; acc2[p][1] = bias; }
        unsigned short raw[38];
        #pragma unroll
        for (int jj = 0; jj < 38; ++jj) raw[jj] = up[jj * 256];
        __builtin_amdgcn_sched_barrier(0);
        #pragma unroll
        for (int jj = 0; jj < 38; ++jj) {
          const float val = __uint_as_float(((unsigned)raw[jj]) << 16);
          f32x2 v2; v2[0] = val; v2[1] = val;
          #pragma unroll
          for (int p = 0; p < 4; ++p) {
            if (jj - 2 * p >= 0 && jj - 2 * p <= 31) acc2[p] = W2[jj - 2 * p] * v2 + acc2[p];
          }
        }
        #pragma unroll
        for (int p = 0; p < 4; ++p) { O[(r0 + 2 * p) * 256 + c] = acc2[p][0]; O[(r0 + 2 * p + 1) * 256 + c] = acc2[p][1]; }
      }
    }
    uint2 zg[8];
    #pragma unroll
    for (int i = 0; i < 8; ++i) zg[i] = ld8_nt(z + (tokbase + t0 + w * 8 + i) * ZC + Z_CFG + lane * 4);
    __syncthreads();

    {
      const float4 lg = *(const float4*)(P.ln_cf_g + lq * 256 + lane * 4);
      const float4 lb = *(const float4*)(P.ln_cf_b + lq * 256 + lane * 4);
      float4 xva[8];
      #pragma unroll
      for (int i = 0; i < 8; ++i) xva[i] = *(const float4*)(O + (w * 8 + i) * 256 + lane * 4);
      __builtin_amdgcn_sched_barrier(0);
      #pragma unroll
      for (int i = 0; i < 8; ++i) {
        const int ti = w * 8 + i;
        const float4 xv = xva[i];
        const float s = wave_sum(xv.x + xv.y + xv.z + xv.w);
        const float mu = s * (1.f / 256.f);
        float d0 = xv.x - mu, d1 = xv.y - mu, d2 = xv.z - mu, d3 = xv.w - mu;
        const float q = wave_sum(d0 * d0 + d1 * d1 + d2 * d2 + d3 * d3);
        const float rstd = rsqrtf(q * (1.f / 256.f) + 1e-5f);
        const size_t tok = tokbase + t0 + ti;
        float y0 = silu_f(d0 * rstd * lg.x + lb.x) * bflo(zg[i].x);
        float y1 = silu_f(d1 * rstd * lg.y + lb.y) * bfhi(zg[i].x);
        float y2 = silu_f(d2 * rstd * lg.z + lb.z) * bflo(zg[i].y);
        float y3 = silu_f(d3 * rstd * lg.w + lb.w) * bfhi(zg[i].y);
        uint2 ov; ov.x = pk2(y0, y1); ov.y = pk2(y2, y3);
        *(uint2*)(mb + tok * D + 768 + lane * 4) = ov;
      }
    }
    if (!has_next) break;
    cur = nxt; task = ntask; ++iters;
  }
  __syncthreads();
}

DI void phase_mixer(const Params& P, int wv, int l, char* lds, int which = 3) {
  const bool last = (l == DEPTH - 1);
  const int n_attn = last ? 4096 : 4352;
  const int n_conv = last ? 1024 : 1088;
  const int G = gridDim.x;
  const int nr = (n_attn + G - 1) / G;
  const int L = logical_block();
  int l2 = l;
  asm volatile("" : "+s"(l2));
  if (which & 1) attn_loop(P, wv, l2, n_attn, lds, 0, nr);
  asm volatile("" : "+s"(l2));
  if (which & 2) conv_loop(P, wv, l2, n_conv, L, lds, 1000);
}

#define XB_TMO      128
#define XB_XCNT(j)  (256  + 64 * (j))
#define XB_XSUB(j)  (1280 + 64 * (j))
#define XB_XGEN(j)  (2304 + 64 * (j))
#define XB_TOP      3328
#define XB_TOPGEN   3392
#define XCD_BAR_WORDS 3456
#define XB_SPIN_CAP (1u << 18)
DI unsigned xb_ld(unsigned* p)              { return __hip_atomic_load(p, __ATOMIC_RELAXED, __HIP_MEMORY_SCOPE_AGENT); }
DI unsigned xb_add(unsigned* p, unsigned v) { return __hip_atomic_fetch_add(p, v, __ATOMIC_RELAXED, __HIP_MEMORY_SCOPE_AGENT); }
DI unsigned xb_xcc_id() { return (unsigned)__builtin_amdgcn_s_getreg((3 << 11) | 20) & 0xFu; }
#define XB_SPIN(cond, bar) do { unsigned _sp = 0; while (cond) { __builtin_amdgcn_s_sleep(1); \
    if ((++_sp & 255u) == 0u) { if (xb_ld(&(bar)[XB_TMO])) break; if (_sp > XB_SPIN_CAP) { atomicAdd(&(bar)[XB_TMO], 1u); break; } } } } while (0)
struct XcdBarrier { unsigned* bar; unsigned x; volatile LAS unsigned* st; };
DI XcdBarrier xcd_barrier_post(unsigned* bar, volatile LAS unsigned* st) {
  XcdBarrier b; b.bar = bar; b.x = xb_xcc_id(); b.st = st;
  if (threadIdx.x == 0) (void)xb_add(&bar[XB_XCNT(b.x)], 1u);
  return b;
}
DI void xcd_barrier_complete(unsigned* bar, unsigned x, unsigned& nloc, unsigned& nx) {
  const unsigned G = gridDim.x * gridDim.y * gridDim.z;
  unsigned sum, cnt, mine, sp = 0u;
  for (;;) {
    sum = 0u; cnt = 0u; mine = 0u;
    #pragma unroll
    for (unsigned j = 0; j < 16; ++j) { const unsigned c = xb_ld(&bar[XB_XCNT(j)]); sum += c; cnt += (c > 0u) ? 1u : 0u; mine = (j == x) ? c : mine; }
    if (sum == G) break;
    __builtin_amdgcn_s_sleep(1);
    if ((++sp & 255u) == 0u) { if (xb_ld(&bar[XB_TMO])) break; if (sp > XB_SPIN_CAP) { atomicAdd(&bar[XB_TMO], 1u); break; } }
  }
  nloc = mine > 0u ? mine : 1u; nx = cnt > 0u ? cnt : 1u;
}
DI void xcd_barrier(const XcdBarrier& b) {
  asm volatile("s_waitcnt vmcnt(0)" ::: "memory");
  __syncthreads();
  if (threadIdx.x == 0) {
    unsigned* bar = b.bar;
    __builtin_amdgcn_s_waitcnt(0);
    unsigned nloc = b.st[0], nx = b.st[1];
    if (nloc == 0u) { xcd_barrier_complete(bar, b.x, nloc, nx); b.st[0] = nloc; b.st[1] = nx; }
    const unsigned old = xb_add(&bar[XB_XSUB(b.x)], 1u);
    const unsigned gen = old / nloc;
    if (old + 1u == (gen + 1u) * nloc) {
      __builtin_amdgcn_fence(__ATOMIC_RELEASE, "agent");
      asm volatile("s_waitcnt vmcnt(0)" ::: "memory");
      const unsigned og = xb_add(&bar[XB_TOP], 1u);
      const unsigned tg = og / nx;
      if (og + 1u == (tg + 1u) * nx) xb_add(&bar[XB_TOPGEN], 1u);
      else XB_SPIN(xb_ld(&bar[XB_TOPGEN]) == tg, bar);
      __builtin_amdgcn_fence(__ATOMIC_ACQUIRE, "agent");
      xb_add(&bar[XB_XGEN(b.x)], 1u);
      asm volatile("s_waitcnt vmcnt(0)" ::: "memory");
    } else {
      XB_SPIN(xb_ld(&bar[XB_XGEN(b.x)]) == gen, bar);
      __builtin_amdgcn_fence(__ATOMIC_ACQUIRE, "agent");
      asm volatile("s_waitcnt vmcnt(0)" ::: "memory");
    }
  }
  __syncthreads();
}

constexpr int NPHASE = 18;
template <bool COOP>
__global__ void __launch_bounds__(512) mk_kernel(Params P, int ph_lo, int ph_hi) {
  extern __shared__ __attribute__((aligned(16))) char lds[];
  const int wv = __builtin_amdgcn_readfirstlane((int)(threadIdx.x >> 6));
  XcdBarrier xb;
  if (COOP) {
    volatile LAS unsigned* st = (volatile LAS unsigned*)((LAS char*)lds + LDS_WORK);
    if (threadIdx.x == 0) { st[0] = 0u; st[1] = 0u; }
    __syncthreads();
    xb = xcd_barrier_post((unsigned*)(P.ws + WS_BAR), st);
  }
  for (int ph = ph_lo; ph < ph_hi; ++ph) {
    if (ph == 0) phase0(P, wv, lds);
    else if (ph == NPHASE - 1) phase_resnorm(P, wv, DEPTH);
    else {
      const int l = (ph - 1) >> 2, s = (ph - 1) & 3;
      if (s == 0) { phase_resnorm(P, wv, l); }
      else if (s == 1) { phase_inproj(P, wv, l, lds); if (PROBE == 2) { cg::this_grid().sync(); phase_inproj(P, wv, l, lds); } }
      else if (s == 2) { phase_mixer(P, wv, l, lds); if (PROBE == 4) { cg::this_grid().sync(); phase_mixer(P, wv, l, lds, 1); } if (PROBE == 5) { cg::this_grid().sync(); phase_mixer(P, wv, l, lds, 2); } }
      else { phase_outproj(P, wv, l, lds); if (PROBE == 6) { cg::this_grid().sync(); phase_outproj(P, wv, l, lds); } }
    }
    if (COOP) { if (ph + 1 < ph_hi) {
      if (ph_hi > NPHASE) cg::this_grid().sync(); else xcd_barrier(xb);
    } }
  }
}

extern "C" void kernel_launch(void* const* d_in, const int* in_sizes, int n_in, void* d_out, int out_size,
                              void* d_ws, size_t ws_size, hipStream_t stream) {
  static int grid = 0;
  if (grid == 0) {
    if (n_in != 16 || out_size != ML * D || ws_size < WS_END) {
      fprintf(stderr, "kernel_launch: unexpected shapes n_in %d out %d ws %zu (need %zu)\n", n_in, out_size, ws_size, (size_t)WS_END);
      grid = -1; return;
    }
    int dev = 0, cus = 0, per_cu = 0;
    hipGetDevice(&dev);
    hipDeviceGetAttribute(&cus, hipDeviceAttributeMultiprocessorCount, dev);
    const void* fn = MK_COOP ? (const void*)mk_kernel<true> : (const void*)mk_kernel<false>;
    if (hipFuncSetAttribute(fn, hipFuncAttributeMaxDynamicSharedMemorySize, LDS_BYTES) != hipSuccess) {
      fprintf(stderr, "kernel_launch: hipFuncSetAttribute failed\n"); grid = -1; return;
    }
    if (hipOccupancyMaxActiveBlocksPerMultiprocessor(&per_cu, fn, 512, LDS_BYTES) != hipSuccess || per_cu < 1) {
      fprintf(stderr, "kernel_launch: occupancy query gave %d\n", per_cu); per_cu = 1;
    }
    (void)hipGetLastError();
    grid = cus * 1;
  }
  if (grid < 0) return;
  Params p{};
  p.x = (const float*)d_in[0]; p.c = (const float*)d_in[1]; p.ctx = (const float*)d_in[2]; p.c_ctx = (const float*)d_in[3];
  p.norm_g = (const float*)d_in[4]; p.w_ada = (const float*)d_in[5]; p.b_ada = (const float*)d_in[6]; p.w_in = (const float*)d_in[7];
  p.conv_sc = (const float*)d_in[8]; p.rpb = (const float*)d_in[9]; p.conv_cf = (const float*)d_in[10]; p.conv_cf_b = (const float*)d_in[11];
  p.ln_cf_g = (const float*)d_in[12]; p.ln_cf_b = (const float*)d_in[13]; p.w_out = (const float*)d_in[14]; p.final_g = (const float*)d_in[15];
  p.out = (float*)d_out; p.ws = (unsigned char*)d_ws;
  hipMemsetAsync((char*)d_ws + WS_MOD, 0, MOD_BYTES + XCD_BAR_WORDS * 4, stream);
#if MK_COOP
  int lo = 0, hi = NPHASE;
  void* args[] = {&p, &lo, &hi};
  hipError_t e = hipLaunchCooperativeKernel((const void*)mk_kernel<true>, dim3(grid), dim3(512), args, LDS_BYTES, stream);
  if (e != hipSuccess) fprintf(stderr, "cooperative launch failed: %s (grid %d)\n", hipGetErrorString(e), grid);
#else
  for (int ph = 0; ph < NPHASE; ++ph)
    hipLaunchKernelGGL(mk_kernel<false>, dim3(grid), dim3(512), LDS_BYTES, stream, p, ph, ph + 1);
#endif
}
```

```cpp
#include <hip/hip_runtime.h>
#include <hip/hip_cooperative_groups.h>
#include <cstdio>
namespace cg = cooperative_groups;

#ifndef PROBE
#define PROBE 0
#endif
#ifndef MK_COOP
#define MK_COOP 1
#endif

typedef unsigned short u16;
using bf16x8 = __attribute__((ext_vector_type(8))) short;
using s16x4  = __attribute__((ext_vector_type(4))) short;
using f32x4  = __attribute__((ext_vector_type(4))) float;
using u32x4  = __attribute__((ext_vector_type(4))) unsigned;
using f32x2  = __attribute__((ext_vector_type(2))) float;
using u32x2  = __attribute__((ext_vector_type(2))) unsigned;
typedef __attribute__((ext_vector_type(2))) __bf16 bf2_t;
#define DI __device__ __forceinline__

constexpr int D = 1024, NB = 16, SEQ = 4096, NCTX = 256, DP = 3840, DEPTH = 4;
constexpr int ZC = 3072, Z_SCV = 0, Z_SCG = 256, Z_Q = 512, Z_K = 1024, Z_V = 1536, Z_NG = 2048, Z_CFU = 2560, Z_CFG = 2816;
constexpr int ML = NB * SEQ;
constexpr int MC = NB * NCTX;
constexpr int MT = ML + MC;
constexpr int NTT = MT / 256;
constexpr int LDS_WORK = 131072;
constexpr int LDS_BYTES = LDS_WORK + 16;

constexpr size_t WS_WIN  = 0;
constexpr size_t WS_WOUT = WS_WIN + (size_t)DEPTH * DP * D * 2;
constexpr size_t WS_MOD  = WS_WOUT + (size_t)DEPTH * D * D * 2;
constexpr size_t MOD_BYTES = (size_t)DEPTH * 17 * 3072 * 4;
constexpr size_t WS_BAR  = WS_MOD + MOD_BYTES;
constexpr size_t WS_CTX  = WS_MOD + 1048576;
constexpr size_t WS_HM   = WS_CTX + (size_t)MC * D * 4;
constexpr size_t WS_Z    = WS_HM + (size_t)MT * D * 2;
constexpr size_t WS_Y    = WS_Z + (size_t)MT * DP * 2;
constexpr size_t WS_END  = WS_Y + (size_t)MT * D * 2;

struct Params {
  const float *x, *c, *ctx, *c_ctx, *norm_g, *w_ada, *b_ada, *w_in, *conv_sc, *rpb, *conv_cf, *conv_cf_b, *ln_cf_g, *ln_cf_b, *w_out, *final_g;
  float* out;
  unsigned char* ws;
};

DI float fexp2(float v) { return __builtin_amdgcn_exp2f(v); }
DI float sigmoid_f(float v) { return __builtin_amdgcn_rcpf(1.f + fexp2(-1.4426950408889634f * v)); }
DI float silu_f(float v) { return v * sigmoid_f(v); }
DI unsigned pk2(float a, float b) { bf2_t v; v[0] = (__bf16)a; v[1] = (__bf16)b; return __builtin_bit_cast(unsigned, v); }
DI float bflo(unsigned w) { return __uint_as_float(w << 16); }
DI float bfhi(unsigned w) { return __uint_as_float(w & 0xffff0000u); }
DI void unpack8(const uint4& v, float* f) {
  f[0] = bflo(v.x); f[1] = bfhi(v.x); f[2] = bflo(v.y); f[3] = bfhi(v.y);
  f[4] = bflo(v.z); f[5] = bfhi(v.z); f[6] = bflo(v.w); f[7] = bfhi(v.w);
}
DI int opaque_tid(int wv) {
  unsigned m = ~0u;
  asm volatile("" : "+s"(m));
  int t = wv * 64 + (int)__builtin_amdgcn_mbcnt_hi(m, __builtin_amdgcn_mbcnt_lo(m, 0u));
  asm volatile("" : "+v"(t)); return t;
}
DI void st16_wt(void* p, const uint4& v) {
  u32x4 d; d[0] = v.x; d[1] = v.y; d[2] = v.z; d[3] = v.w;
  asm volatile("global_store_dwordx4 %0, %1, off sc1" :: "v"(p), "v"(d) : "memory");
}
template <int CTRL, int RMASK> DI float dpp0(float x) { return __int_as_float(__builtin_amdgcn_update_dpp(0, __float_as_int(x), CTRL, RMASK, 0xf, false)); }
DI float wave_sum(float x) {
  x += dpp0<0xB1, 0xf>(x);
  x += dpp0<0x4E, 0xf>(x);
  x += dpp0<0x124, 0xf>(x);
  x += dpp0<0x128, 0xf>(x);
  x += dpp0<0x142, 0xa>(x);
  x += dpp0<0x143, 0xc>(x);
  return __int_as_float(__builtin_amdgcn_readlane(__float_as_int(x), 63));
}
DI void st16_nt(void* p, const uint4& v) {
  u32x4 d; d[0] = v.x; d[1] = v.y; d[2] = v.z; d[3] = v.w;
  __builtin_nontemporal_store(d, (u32x4*)p);
}
DI uint4 ld16_nt(const void* p) { const u32x4 t = __builtin_nontemporal_load((const u32x4*)p); return make_uint4(t[0], t[1], t[2], t[3]); }
DI uint2 ld8_nt(const void* p) { const u32x2 t = __builtin_nontemporal_load((const u32x2*)p); return make_uint2(t[0], t[1]); }
DI int clampi(int v, int lo, int hi) { return v < lo ? lo : (v > hi ? hi : v); }

#define LAS __attribute__((address_space(3)))
constexpr int BM = 256, BK = 64, HALF = 128, HTB = HALF * BK * 2;
DI int lds_byte(int r, int c) { const int st = (r >> 4) * 2 + (c >> 5), rr = r & 15, cc = c & 31, ob = rr * 64 + cc * 2; return st * 1024 + (ob ^ (((ob >> 9) & 1) << 5)); }
DI void stage_rc(int b, int& R, int& C) { const int st = b / 1024, sb = b % 1024, swz = sb ^ (((sb >> 9) & 1) << 5); R = (st >> 1) * 16 + swz / 64; C = (st & 1) * 32 + (swz % 64) / 2; }
DI int perm32(int rho) { const int n = rho >> 4, i = rho & 15; return 8 * (i >> 2) + 4 * n + (i & 3); }

DI int win_src_col(int n) {
  const int pn = n >> 8, r = n & 255, half = r >> 7, q = r & 127;
  if (pn == 0 || pn == 1) return (half ? 512 : 0) + pn * 128 + q;
  if (pn == 2 || pn == 3) return (half ? 768 : 256) + (pn - 2) * 128 + q;
  if (pn == 12 || pn == 13) return (half ? 3328 : 3072) + (pn - 12) * 128 + q;
  return n;
}

DI int logical_block() {
  int g = gridDim.x;
  if ((g & 7) == 0) return (blockIdx.x & 7) * (g >> 3) + (blockIdx.x >> 3);
  return blockIdx.x;
}

template <bool PERM, class Epi>
DI void gemm_phase(const Params& P, int wv, const u16* __restrict__ Aact, const u16* __restrict__ Wt, int ntiles, int nct, LAS unsigned char* lds, Epi&& E) {
  constexpr int K = 1024, nt = K / BK;
  const int tid = opaque_tid(wv), wid = tid >> 6, lane = tid & 63, wr = wid >> 2, wc = wid & 3, fr = lane & 15, fq = lane >> 4;
  const int G = gridDim.x;
  unsigned voffA[2], voffB[2];
  #pragma unroll
  for (int i = 0; i < 2; ++i) { int R, C; stage_rc(tid * 16 + i * 8192, R, C); const int Rb = PERM ? ((R & ~31) + perm32(R & 31)) : R;
    voffA[i] = (unsigned)(R * K + C) * 2u; voffB[i] = (unsigned)(Rb * K + C) * 2u; }
  const size_t kstep = (size_t)(BK * 2), hstep = (size_t)HALF * K * 2, tstep = 2 * hstep;
  const unsigned ldsw = (unsigned)wid * 1024u;
  const int aoff = lds_byte(wr * 64 + fr, fq * 8), boff = lds_byte(wc * 32 + fr, fq * 8);
  #define G_SA(b, h) (((b) * 2 + (h)) * HTB)
  #define G_SB(b, h) ((4 + (b) * 2 + (h)) * HTB)
  #define G_STAGE(bufoff, gbase, voff) do { _Pragma("unroll") for (int _i = 0; _i < 2; ++_i) \
      __builtin_amdgcn_global_load_lds((const unsigned*)((const char*)(gbase) + (voff)[_i]), (LAS unsigned*)(lds + (bufoff) + ldsw + _i * 8192), 16, 0, 0); } while (0)
  #define G_LDA(dst, b, h) do { _Pragma("unroll") for (int m = 0; m < 4; ++m) _Pragma("unroll") for (int k = 0; k < 2; ++k) dst[m][k] = *(const LAS bf16x8*)(lds + G_SA(b, h) + aoff + m * 2048 + k * 1024); } while (0)
  #define G_LDB(dst, b, h) do { _Pragma("unroll") for (int n = 0; n < 2; ++n) _Pragma("unroll") for (int k = 0; k < 2; ++k) dst[n][k] = *(const LAS bf16x8*)(lds + G_SB(b, h) + boff + n * 2048 + k * 1024); } while (0)
  #define G_MMA(ai, bj, At, Bt) do { __builtin_amdgcn_s_setprio(1); _Pragma("unroll") for (int m = 0; m < 4; ++m) _Pragma("unroll") for (int n = 0; n < 2; ++n) _Pragma("unroll") for (int k = 0; k < 2; ++k) \
      acc[ai][bj][m][n] = __builtin_amdgcn_mfma_f32_16x16x32_bf16(Bt[n][k], At[m][k], acc[ai][bj][m][n], 0, 0, 0); __builtin_amdgcn_s_setprio(0); } while (0)
  #define G_WAIT_V(n) asm volatile("s_waitcnt vmcnt(" #n ")" ::: "memory")
  #define G_WAIT_L(n) asm volatile("s_waitcnt lgkmcnt(" #n ")" ::: "memory")
  #define G_BAR __builtin_amdgcn_s_barrier()
  #define G_SCHED __builtin_amdgcn_sched_barrier(0)
  const int ntm = ntiles / nct;
  auto unit = [&](int i, int& pm, int& pn) __attribute__((always_inline)) -> bool {
    const int Lg = i * G + blockIdx.x;
    if (Lg >= ntiles) return false;
    int wg = Lg;
    { const int q = ntiles >> 3, r = ntiles & 7, xcd = wg & 7, off = wg >> 3; wg = (xcd < r ? xcd * (q + 1) : r * (q + 1) + (xcd - r) * q) + off; }
    const int nig = 8 * nct, gid = wg / nig, fm = gid * 8, gsz = (ntm - fm) < 8 ? (ntm - fm) : 8;
    const int rem = wg - gid * nig;
    pm = fm + rem % gsz; pn = rem / gsz; return true;
  };
  int ui = 0, cpm, cpn, npm = 0, npn = 0;
  if (!unit(0, cpm, cpn)) return;
  f32x4 acc[2][2][4][2];
  #pragma unroll
  for (int a = 0; a < 2; ++a)
  #pragma unroll
    for (int b = 0; b < 2; ++b)
  #pragma unroll
      for (int m = 0; m < 4; ++m)
  #pragma unroll
        for (int n = 0; n < 2; ++n) acc[a][b][m][n] = (f32x4){0.f, 0.f, 0.f, 0.f};
  bf16x8 At[4][2], B0[2][2], B1[2][2];
  const char* cA = (const char*)Aact + (size_t)cpm * tstep; const char* cB = (const char*)Wt + (size_t)cpn * tstep;
  G_WAIT_V(0);
  G_STAGE(G_SB(0, 0), cB, voffB); G_STAGE(G_SA(0, 0), cA, voffA); G_STAGE(G_SB(0, 1), cB + hstep, voffB); G_STAGE(G_SA(0, 1), cA + hstep, voffA);
  if (wr == 1) G_BAR;
  G_WAIT_V(4); G_BAR;
  G_STAGE(G_SB(1, 0), cB + kstep, voffB); G_STAGE(G_SA(1, 0), cA + kstep, voffA); G_STAGE(G_SB(1, 1), cB + hstep + kstep, voffB);
  G_WAIT_V(6); G_BAR;
  for (;;) {
    bool has_next;
    has_next = unit(ui + 1, npm, npn);
    const char* nA = has_next ? (const char*)Aact + (size_t)npm * tstep : cA; const char* nB = has_next ? (const char*)Wt + (size_t)npn * tstep : cB;
    for (int t = 0; t < nt; t += 2) {
      const bool last = (t == nt - 2);
      const char* a1 = cA + (size_t)(t + 1) * kstep;
      const char* a2 = last ? nA : cA + (size_t)(t + 2) * kstep; const char* b2 = last ? nB : cB + (size_t)(t + 2) * kstep;
      const char* a3 = a2 + kstep; const char* b3 = b2 + kstep;
      G_LDB(B0, 0, 0); G_SCHED; G_LDA(At, 0, 0); G_STAGE(G_SA(1, 1), a1 + hstep, voffA);
      G_WAIT_L(8); G_BAR; G_WAIT_L(0); G_MMA(0, 0, At, B0); G_BAR; G_SCHED;
      G_LDB(B1, 0, 1); G_STAGE(G_SB(0, 0), b2, voffB);
      G_BAR; G_WAIT_L(0); G_MMA(0, 1, At, B1); G_BAR;
      G_LDA(At, 0, 1); G_STAGE(G_SA(0, 0), a2, voffA);
      G_BAR; G_WAIT_L(0); G_MMA(1, 0, At, B0); G_BAR; G_SCHED;
      G_STAGE(G_SB(0, 1), b2 + hstep, voffB);
      G_WAIT_V(6); G_BAR; G_MMA(1, 1, At, B1); G_BAR;
      G_LDB(B0, 1, 0); G_SCHED; G_LDA(At, 1, 0); G_STAGE(G_SA(0, 1), a2 + hstep, voffA);
      G_WAIT_L(8); G_BAR; G_WAIT_L(0); G_MMA(0, 0, At, B0); G_BAR; G_SCHED;
      G_LDB(B1, 1, 1); G_STAGE(G_SB(1, 0), b3, voffB);
      G_BAR; G_WAIT_L(0); G_MMA(0, 1, At, B1); G_BAR;
      G_LDA(At, 1, 1); G_STAGE(G_SA(1, 0), a3, voffA);
      G_BAR; G_WAIT_L(0); G_MMA(1, 0, At, B0); G_BAR; G_SCHED;
      G_STAGE(G_SB(1, 1), b3 + hstep, voffB);
      G_WAIT_V(6); G_BAR; G_MMA(1, 1, At, B1); G_BAR;
    }
    E(acc, cpm, cpn, wr, wc, fr, fq);
    if (!has_next) break;
    #pragma unroll
    for (int a = 0; a < 2; ++a)
    #pragma unroll
      for (int b = 0; b < 2; ++b)
    #pragma unroll
        for (int m = 0; m < 4; ++m)
    #pragma unroll
          for (int n = 0; n < 2; ++n) acc[a][b][m][n] = (f32x4){0.f, 0.f, 0.f, 0.f};
    cpm = npm; cpn = npn; cA = nA; cB = nB; ++ui;
  }
  G_WAIT_V(0);
  if (wr == 0) G_BAR;
  G_BAR;
  #undef G_SA
  #undef G_SB
  #undef G_STAGE
  #undef G_LDA
  #undef G_LDB
  #undef G_MMA
  #undef G_WAIT_V
  #undef G_WAIT_L
  #undef G_BAR
  #undef G_SCHED
}

DI void transpose_tiles(const Params& P, int tid, char* lds, int l, int first, int stride) {
  u16* winT = (u16*)(P.ws + WS_WIN) + (size_t)l * DP * D;
  u16* woutT = (u16*)(P.ws + WS_WOUT) + (size_t)l * D * D;
  float* tile = (float*)lds;
  for (int t2 = first; t2 < 960 + 256; t2 += stride) {
    const float* src; u16* dst; int N, kt, ntile, n_src;
    if (t2 < 960) { kt = t2 / 60; ntile = t2 % 60; N = DP; src = P.w_in + (size_t)l * D * DP; dst = winT; n_src = win_src_col(ntile * 64); }
    else { const int r2 = t2 - 960; kt = r2 >> 4; ntile = r2 & 15; N = D; src = P.w_out + (size_t)l * D * D; dst = woutT; n_src = ntile * 64; }
    const int k0 = kt * 64, n0 = ntile * 64;
    {
      const int r = tid >> 4, c4 = tid & 15;
      #pragma unroll
      for (int hh = 0; hh < 2; ++hh) {
        const f32x4 vt = __builtin_nontemporal_load((const f32x4*)(src + (size_t)(k0 + r + hh * 32) * N + n_src + c4 * 4));
        float4 v = make_float4(vt[0], vt[1], vt[2], vt[3]);
        float* tp = tile + (r + hh * 32) * 65 + c4 * 4;
        tp[0] = v.x; tp[1] = v.y; tp[2] = v.z; tp[3] = v.w;
      }
    }
    __syncthreads();
    {
      const int n = tid >> 3, kc = tid & 7;
      float f[8];
      #pragma unroll
      for (int e = 0; e < 8; ++e) f[e] = tile[(kc * 8 + e) * 65 + n];
      uint4 o; o.x = pk2(f[0], f[1]); o.y = pk2(f[2], f[3]); o.z = pk2(f[4], f[5]); o.w = pk2(f[6], f[7]);
      *(uint4*)(dst + (size_t)(n0 + n) * D + k0 + kc * 8) = o;
    }
    __syncthreads();
  }
}

DI void phase0(const Params& P, int wv, char* lds) {
  const int tid = opaque_tid(wv);
  float* mod = (float*)(P.ws + WS_MOD);
  constexpr int NG = 192;
  for (int task = blockIdx.x; task < NG; task += gridDim.x) {
    const int l = task / 48, rem = task % 48, nc = rem >> 3, ks = rem & 7;
    float* s = (float*)lds;
    for (int id = tid; id < 17 * 128; id += 512) {
      int r = id >> 7, kk = id & 127;
      float v = (r < 16) ? P.c[r * D + ks * 128 + kk] : P.c_ctx[ks * 128 + kk];
      s[id] = silu_f(v);
    }
    __syncthreads();
    const int n = nc * 512 + tid;
    float acc[17];
    #pragma unroll
    for (int r = 0; r < 17; ++r) acc[r] = 0.f;
    const float* wp = P.w_ada + ((size_t)l * D + ks * 128) * 3072 + n;
    for (int k4 = 0; k4 < 32; ++k4) {
      float w0 = wp[(size_t)(k4 * 4 + 0) * 3072], w1 = wp[(size_t)(k4 * 4 + 1) * 3072];
      float w2 = wp[(size_t)(k4 * 4 + 2) * 3072], w3 = wp[(size_t)(k4 * 4 + 3) * 3072];
      #pragma unroll
      for (int r = 0; r < 17; ++r) {
        float4 sv = *(const float4*)(s + r * 128 + k4 * 4);
        acc[r] += sv.x * w0 + sv.y * w1 + sv.z * w2 + sv.w * w3;
      }
    }
    const float bias = (ks == 0) ? P.b_ada[l * 3072 + n] : 0.f;
    #pragma unroll
    for (int r = 0; r < 17; ++r) atomicAdd(mod + ((size_t)l * 17 + r) * 3072 + n, acc[r] + bias);
    __syncthreads();
  }
  transpose_tiles(P, tid, lds, 0, (blockIdx.x + gridDim.x - NG % gridDim.x) % gridDim.x, gridDim.x);
}

DI void phase_resnorm(const Params& P, int wv, int l) {
  const int tid = opaque_tid(wv), lane = tid & 63;
  const float* modl = (const float*)(P.ws + WS_MOD) + (size_t)(l < DEPTH ? l : 0) * 17 * 3072;
  const float* modp = (const float*)(P.ws + WS_MOD) + (size_t)(l > 0 ? l - 1 : 0) * 17 * 3072;
  float* ctxs = (float*)(P.ws + WS_CTX);
  u16* h = (u16*)(P.ws + WS_HM);
  const u16* y = (const u16*)(P.ws + WS_Y);
  const bool fin = (l == DEPTH);
  const float* g = fin ? P.final_g : P.norm_g + l * D;
  const int nrows = fin ? ML : MT;
  const int nw = gridDim.x * 8;
  float4 gg[4];
  #pragma unroll
  for (int i = 0; i < 4; ++i) gg[i] = *(const float4*)(g + (i * 64 + lane) * 4);
  for (int row0 = blockIdx.x * 8 + wv; row0 < nrows; row0 += 2 * nw) {
    float4 v[2][4], gt[2][4], sh[2][4], sc[2][4];
    uint2 yv[2][4];
    float* dst[2]; bool ok[2];
    #pragma unroll
    for (int k = 0; k < 2; ++k) {
      const int row = row0 + k * nw;
      ok[k] = row < nrows;
      const int rw = ok[k] ? row : row0;
      const float* src; int rr;
      if (rw < ML) { src = (l <= 1 ? P.x : P.out) + (size_t)rw * D; dst[k] = P.out + (size_t)rw * D; rr = rw >> 12; }
      else { src = (l <= 1 ? P.ctx : ctxs) + (size_t)(rw - ML) * D; dst[k] = ctxs + (size_t)(rw - ML) * D; rr = 16; }
      #pragma unroll
      for (int i = 0; i < 4; ++i) { const f32x4 t = __builtin_nontemporal_load((const f32x4*)(src + (i * 64 + lane) * 4)); v[k][i] = make_float4(t[0], t[1], t[2], t[3]); }
      if (l > 0) {
        #pragma unroll
        for (int i = 0; i < 4; ++i) {
          { const u32x2 t = __builtin_nontemporal_load((const u32x2*)(y + (size_t)rw * D + (i * 64 + lane) * 4)); yv[k][i] = make_uint2(t[0], t[1]); }
          gt[k][i] = *(const float4*)(modp + rr * 3072 + 2048 + (i * 64 + lane) * 4);
        }
      }
      if (!fin) {
        #pragma unroll
        for (int i = 0; i < 4; ++i) {
          sh[k][i] = *(const float4*)(modl + rr * 3072 + (i * 64 + lane) * 4);
          sc[k][i] = *(const float4*)(modl + rr * 3072 + 1024 + (i * 64 + lane) * 4);
        }
      }
    }
    __builtin_amdgcn_sched_barrier(0);
    #pragma unroll
    for (int k = 0; k < 2; ++k) {
      if (!ok[k]) continue;
      const int row = row0 + k * nw;
      float ss = 0.f;
      if (l > 0) {
        #pragma unroll
        for (int i = 0; i < 4; ++i) {
          v[k][i].x += gt[k][i].x * bflo(yv[k][i].x); v[k][i].y += gt[k][i].y * bfhi(yv[k][i].x);
          v[k][i].z += gt[k][i].z * bflo(yv[k][i].y); v[k][i].w += gt[k][i].w * bfhi(yv[k][i].y);
          if (!fin) { f32x4 t; t[0] = v[k][i].x; t[1] = v[k][i].y; t[2] = v[k][i].z; t[3] = v[k][i].w; __builtin_nontemporal_store(t, (f32x4*)(dst[k] + (i * 64 + lane) * 4)); }
        }
      }
      #pragma unroll
      for (int i = 0; i < 4; ++i) ss += v[k][i].x * v[k][i].x + v[k][i].y * v[k][i].y + v[k][i].z * v[k][i].z + v[k][i].w * v[k][i].w;
      ss = wave_sum(ss);
      const float rstd = rsqrtf(ss * (1.f / D) + 1e-6f);
      if (fin) {
        #pragma unroll
        for (int i = 0; i < 4; ++i) {
          const int c = (i * 64 + lane) * 4;
          float4 o; o.x = v[k][i].x * rstd * gg[i].x; o.y = v[k][i].y * rstd * gg[i].y; o.z = v[k][i].z * rstd * gg[i].z; o.w = v[k][i].w * rstd * gg[i].w;
          *(float4*)(dst[k] + c) = o;
        }
      } else {
        #pragma unroll
        for (int i = 0; i < 4; ++i) {
          const int c = (i * 64 + lane) * 4;
          const float a0 = v[k][i].x * rstd * gg[i].x * (1.f + sc[k][i].x) + sh[k][i].x;
          const float a1 = v[k][i].y * rstd * gg[i].y * (1.f + sc[k][i].y) + sh[k][i].y;
          const float a2 = v[k][i].z * rstd * gg[i].z * (1.f + sc[k][i].z) + sh[k][i].z;
          const float a3 = v[k][i].w * rstd * gg[i].w * (1.f + sc[k][i].w) + sh[k][i].w;
          uint2 o; o.x = pk2(a0, a1); o.y = pk2(a2, a3);
          *(uint2*)(h + (size_t)row * D + c) = o;
        }
      }
    }
  }
}

DI void phase_inproj(const Params& P, int wv, int l, char* lds) {
  const u16* W = (const u16*)(P.ws + WS_WIN) + (size_t)l * DP * D;
  const u16* h = (const u16*)(P.ws + WS_HM);
  u16* z = (u16*)(P.ws + WS_Z);
  constexpr int NCT = DP / 256;
  gemm_phase<true>(P, wv, h, W, NTT * NCT, NCT, (LAS unsigned char*)lds,
    [&](const f32x4 (&acc)[2][2][4][2], int pm, int pn, int wr, int wc, int fr, int fq) __attribute__((always_inline)) {
      const int row0 = pm * BM + wr * 64 + fr, cw = wc * 32 + 8 * fq;
      if (pn >= 4 && pn < 10) {
        u16* zp = z + Z_Q + (pn - 4) * 256 + cw;
        #pragma unroll
        for (int ai = 0; ai < 2; ++ai)
        #pragma unroll
          for (int m = 0; m < 4; ++m) {
            u16* rowp = zp + (size_t)(row0 + ai * HALF + m * 16) * ZC;
            #pragma unroll
            for (int bj = 0; bj < 2; ++bj) {
              const f32x4 v0 = acc[ai][bj][m][0], v1 = acc[ai][bj][m][1];
              uint4 o; o.x = pk2(v0[0], v0[1]); o.y = pk2(v0[2], v0[3]); o.z = pk2(v1[0], v1[1]); o.w = pk2(v1[2], v1[3]);
              if (pn < 6) st16_nt(rowp + bj * HALF, o); else *(uint4*)(rowp + bj * HALF) = o;
            }
          }
      } else if (pn == 10 || pn == 11 || pn == 14) {
        u16* zp = z + (pn == 14 ? Z_CFG : Z_NG + (pn - 10) * 256) + cw;
        #pragma unroll
        for (int ai = 0; ai < 2; ++ai)
        #pragma unroll
          for (int m = 0; m < 4; ++m) {
            u16* rowp = zp + (size_t)(row0 + ai * HALF + m * 16) * ZC;
            #pragma unroll
            for (int bj = 0; bj < 2; ++bj) {
              const f32x4 v0 = acc[ai][bj][m][0], v1 = acc[ai][bj][m][1];
              uint4 o; o.x = pk2(silu_f(v0[0]), silu_f(v0[1])); o.y = pk2(silu_f(v0[2]), silu_f(v0[3]));
              o.z = pk2(silu_f(v1[0]), silu_f(v1[1])); o.w = pk2(silu_f(v1[2]), silu_f(v1[3]));
              st16_nt(rowp + bj * HALF, o);
            }
          }
      } else {
        const int mode = (pn < 2) ? 0 : (pn < 4 ? 1 : 2);
        const int ob = (pn < 2) ? Z_SCV + pn * 128 : (pn < 4 ? Z_SCG + (pn - 2) * 128 : Z_CFU + (pn - 12) * 128);
        u16* zp = z + ob + cw;
        #pragma unroll
        for (int ai = 0; ai < 2; ++ai)
        #pragma unroll
          for (int m = 0; m < 4; ++m) {
            float o8[8];
            #pragma unroll
            for (int n = 0; n < 2; ++n)
            #pragma unroll
              for (int j = 0; j < 4; ++j) {
                const float a = acc[ai][0][m][n][j], b = acc[ai][1][m][n][j];
                o8[n * 4 + j] = a * (mode == 0 ? b : (mode == 1 ? silu_f(b) : sigmoid_f(b)));
              }
            uint4 o; o.x = pk2(o8[0], o8[1]); o.y = pk2(o8[2], o8[3]); o.z = pk2(o8[4], o8[5]); o.w = pk2(o8[6], o8[7]);
            st16_nt(zp + (size_t)(row0 + ai * HALF + m * 16) * ZC, o);
          }
      }
    });
}

DI void phase_outproj(const Params& P, int wv, int l, char* lds) {
  const u16* W = (const u16*)(P.ws + WS_WOUT) + (size_t)l * D * D;
  const u16* mm = (const u16*)(P.ws + WS_HM);
  u16* y = (u16*)(P.ws + WS_Y);
  const int ntt = (l == DEPTH - 1) ? (ML / 256) : NTT;
  gemm_phase<true>(P, wv, mm, W, ntt * 4, 4, (LAS unsigned char*)lds,
    [&](const f32x4 (&acc)[2][2][4][2], int pm, int pn, int wr, int wc, int fr, int fq) __attribute__((always_inline)) {
      const int row0 = pm * BM + wr * 64 + fr, col0 = pn * BM + wc * 32 + 8 * fq;
      #pragma unroll
      for (int ai = 0; ai < 2; ++ai)
      #pragma unroll
        for (int m = 0; m < 4; ++m) {
          u16* rowp = y + (size_t)(row0 + ai * HALF + m * 16) * D + col0;
          #pragma unroll
          for (int bj = 0; bj < 2; ++bj) {
            const f32x4 v0 = acc[ai][bj][m][0], v1 = acc[ai][bj][m][1];
            uint4 o; o.x = pk2(v0[0], v0[1]); o.y = pk2(v0[2], v0[3]); o.z = pk2(v1[0], v1[1]); o.w = pk2(v1[2], v1[3]);
            *(uint4*)(rowp + bj * HALF) = o;
          }
        }
    });
  if (l + 1 < DEPTH) {
    const int busy = ntt * 4 - 4 * (int)gridDim.x;
    if (busy > 0 && busy < (int)gridDim.x && (int)blockIdx.x >= busy)
      transpose_tiles(P, opaque_tid(wv), lds, l + 1, (int)blockIdx.x - busy, (int)gridDim.x - busy);
    else if (busy <= 0 || busy >= (int)gridDim.x)
      transpose_tiles(P, opaque_tid(wv), lds, l + 1, (int)blockIdx.x, (int)gridDim.x);
  }
}

constexpr int BIAS_OFF = 832 * 128;
struct AttnTask { int b, h, r0, half, lat; };
DI AttnTask attn_decode(int task) {
  AttnTask t; t.lat = (task < 4096) ? 1 : 0; t.r0 = 0; t.half = 0;
  if (t.lat) { t.b = task >> 8; t.h = (task >> 5) & 7; t.r0 = (task & 31) * 2; }
  else { const int t2 = task - 4096; t.b = t2 >> 4; t.h = (t2 >> 1) & 7; t.half = t2 & 1; }
  return t;
}

DI void attn_loop(const Params& P, int wv, int l, int n_attn, char* lds_g, int r_begin, int r_end) {
  LAS char* lds = (LAS char*)lds_g;
  const u16* z = (const u16*)(P.ws + WS_Z);
  u16* mb = (u16*)(P.ws + WS_HM);
  const int tid = opaque_tid(wv);
  const int G = gridDim.x;
  int task = logical_block() + r_begin * G, round = r_begin;
  if (task >= n_attn || r_begin >= r_end) return;

  int lane, fr, fq, w, st_lds, kl0, kl1, tl[4];
  const u16* zl;
  auto lane_consts = [&](int tq) __attribute__((always_inline)) {
    lane = tq & 63; fr = lane & 15; fq = lane >> 4;
    w = __builtin_amdgcn_readfirstlane(tq >> 6);
    const int st_row = tq >> 3, st_c = tq & 7;
    st_lds = st_row * 128 + ((st_c ^ (((st_row >> 1) & 3) << 1) ^ ((st_row >> 3) & 1)) << 4);
    zl = z + (size_t)st_row * ZC + st_c * 8;
    const int ksw = (((fr >> 1) & 3) << 1) ^ (fr >> 3);
    kl0 = fr * 128 + ((fq ^ ksw) << 4);
    kl1 = fr * 128 + (((fq + 4) ^ ksw) << 4);
    const int q4 = fr >> 2, p4 = fr & 3, trow = 4 * fq + q4, tsw = (((trow >> 1) & 3) << 1) ^ (fq >> 1);
    #pragma unroll
    for (int mbk = 0; mbk < 4; ++mbk) tl[mbk] = trow * 128 + (((2 * mbk + (p4 >> 1)) ^ tsw) << 4) + 8 * (p4 & 1);
  };
  lane_consts(tid);
  typedef LAS s16x4* lds_s16x4_p;
  constexpr float LOG2E = 1.4426950408889634f;
  constexpr float SC2 = 0.125f * LOG2E;

  u32x4 rg[13];
  float brg[2];
  auto load_img = [&](const AttnTask& t, int coloff) __attribute__((always_inline)) {
    const size_t ctxbase = (size_t)ML + t.b * NCTX;
    const int rs0 = clampi(t.r0 - 4, 0, 56);
    #pragma unroll
    for (int i = 0; i < 4; ++i) rg[9 + i] = *(const u32x4*)(zl + (ctxbase + i * 64) * ZC + coloff);
    if (t.lat) {
      #pragma unroll
      for (int i = 0; i < 9; ++i) {
        const int gr = min(rs0 + i, 63);
        rg[i] = *(const u32x4*)(zl + ((size_t)t.b * SEQ + gr * 64) * ZC + coloff);
      }
    }
  };
  auto store_img = [&](const AttnTask& t) __attribute__((always_inline)) {
    if (t.lat) {
      #pragma unroll
      for (int i = 0; i < 9; ++i) *(LAS u32x4*)(lds + st_lds + i * 8192) = rg[i];
    }
    #pragma unroll
    for (int i = 0; i < 4; ++i) *(LAS u32x4*)(lds + st_lds + (9 + i) * 8192) = rg[9 + i];
  };
  auto load_bias = [&](const AttnTask& t) __attribute__((always_inline)) {
    if (t.lat) {
      #pragma unroll
      for (int j = 0; j < 2; ++j) {
        const int id = tid + j * 512, ri = id >> 6, ci = (id & 63) - 16;
        brg[j] = (id < 960 && ci >= 0 && ci < 31) ? P.rpb[((size_t)l * 8 + t.h) * 465 + ri * 31 + ci] * LOG2E : 0.f;
      }
    }
  };

  AttnTask cur = attn_decode(task);
  load_img(cur, Z_K + cur.h * 64);
  load_bias(cur);
  if (wv >= 4) __builtin_amdgcn_s_setprio(1);
  for (;;) {
    { int tq = tid; asm volatile("" : "+v"(tq)); lane_consts(tq); }
    store_img(cur);
    if (cur.lat) {
      ((LAS float*)(lds + BIAS_OFF))[tid] = brg[0];
      if (tid < 960 - 512) ((LAS float*)(lds + BIAS_OFF))[tid + 512] = brg[1];
    }
    load_img(cur, Z_V + cur.h * 64);
    const int b = cur.b, h = cur.h;
    const size_t ctxbase = (size_t)ML + b * NCTX;
    const int rs0 = clampi(cur.r0 - 4, 0, 56);
    int r = 0, c0 = 0, rs = 0, rowoff = 0, cb = 0;
    size_t qtok;
    if (cur.lat) {
      r = cur.r0 + (w >> 2); c0 = 16 * (w & 3); rs = clampi(r - 4, 0, 56); rowoff = rs - rs0; cb = clampi(c0 - 8, 0, 32);
      qtok = (size_t)b * SEQ + r * 64 + c0 + fr;
    } else {
      qtok = ctxbase + cur.half * 128 + w * 16 + fr;
    }
    const int wb = (rowoff * 64 + cb) * 128;
    const int pbx = ((cb >> 3) & 1) << 4;
    const bf16x8 qf0 = *(const bf16x8*)(z + qtok * ZC + Z_Q + h * 64 + fq * 8);
    const bf16x8 qf1 = *(const bf16x8*)(z + qtok * ZC + Z_Q + h * 64 + 32 + fq * 8);
    __syncthreads();

    bf16x8 pc[8], pw[8];
    float mc, lc = 0.f, mw = -1e30f, lw = 0.f;
    {
      f32x4 sc[16];
      float mxc = -1e30f;
      bf16x8 fa[4], fb[4];
      #pragma unroll
      for (int u = 0; u < 2; ++u) {
        fa[2 * u]     = *(const LAS bf16x8*)(lds + 73728 + kl0 + u * 2048);
        fa[2 * u + 1] = *(const LAS bf16x8*)(lds + 73728 + kl1 + u * 2048);
      }
      #pragma unroll
      for (int g = 0; g < 8; ++g) {
        if (g + 1 < 8) {
          #pragma unroll
          for (int u = 0; u < 2; ++u) {
            const bf16x8 x0 = *(const LAS bf16x8*)(lds + 73728 + kl0 + (2 * g + 2 + u) * 2048);
            const bf16x8 x1 = *(const LAS bf16x8*)(lds + 73728 + kl1 + (2 * g + 2 + u) * 2048);
            if (g & 1) { fa[2 * u] = x0; fa[2 * u + 1] = x1; } else { fb[2 * u] = x0; fb[2 * u + 1] = x1; }
          }
        }
        __builtin_amdgcn_sched_barrier(0);
        #pragma unroll
        for (int u = 0; u < 2; ++u) {
          const bf16x8 k0 = (g & 1) ? fb[2 * u] : fa[2 * u];
          const bf16x8 k1 = (g & 1) ? fb[2 * u + 1] : fa[2 * u + 1];
          f32x4 a = {0.f, 0.f, 0.f, 0.f};
          a = __builtin_amdgcn_mfma_f32_16x16x32_bf16(k0, qf0, a, 0, 0, 0);
          a = __builtin_amdgcn_mfma_f32_16x16x32_bf16(k1, qf1, a, 0, 0, 0);
          #pragma unroll
          for (int i = 0; i < 4; ++i) mxc = fmaxf(mxc, a[i]);
          sc[2 * g + u] = a;
        }
        __builtin_amdgcn_sched_barrier(0);
      }
      mxc = fmaxf(mxc, __shfl_xor(mxc, 16));
      mxc = fmaxf(mxc, __shfl_xor(mxc, 32));
      mc = mxc * SC2;
      #pragma unroll
      for (int jj = 0; jj < 8; ++jj) {
        float e[8];
        #pragma unroll
        for (int i = 0; i < 4; ++i) { e[i] = fexp2(sc[2 * jj][i] * SC2 - mc); e[4 + i] = fexp2(sc[2 * jj + 1][i] * SC2 - mc); }
        #pragma unroll
        for (int i = 0; i < 8; ++i) lc += e[i];
        u32x4 bu; bu[0] = pk2(e[0], e[1]); bu[1] = pk2(e[2], e[3]); bu[2] = pk2(e[4], e[5]); bu[3] = pk2(e[6], e[7]);
        pc[jj] = __builtin_bit_cast(bf16x8, bu);
      }
    }
    if (cur.lat) {
      const int qc = c0 + fr, cs = clampi(qc - 8, 0, 48);
      bool vm[4];
      int boff[4];
      const int bci = cb - c0 + 15 + 4 * fq - fr + 16;
      #pragma unroll
      for (int i = 0; i < 4; ++i) { const int kc = cb + 4 * fq + i; vm[i] = (kc >= cs) && (kc < cs + 16); boff[i] = bci + i + (vm[i] ? 0 : 16); }
      const LAS float* bl = (const LAS float*)(lds + BIAS_OFF) + (rs - r + 7) * 64;
      const int wk0 = wb + (kl0 ^ pbx), wk1 = wb + (kl1 ^ pbx);
      f32x4 sw[8];
      float mxw = -1e30f;
      bf16x8 fa[4], fb[4];
      float ba[4], bb[4];
      fa[0] = *(const LAS bf16x8*)(lds + wk0); fa[1] = *(const LAS bf16x8*)(lds + wk1);
      fa[2] = *(const LAS bf16x8*)(lds + wk0 + 2048); fa[3] = *(const LAS bf16x8*)(lds + wk1 + 2048);
      #pragma unroll
      for (int i = 0; i < 4; ++i) ba[i] = bl[boff[i]];
      #pragma unroll
      for (int jj = 0; jj < 8; ++jj) {
        if (jj + 1 < 8) {
          const bf16x8 x0 = *(const LAS bf16x8*)(lds + wk0 + (jj + 1) * 8192), x1 = *(const LAS bf16x8*)(lds + wk1 + (jj + 1) * 8192);
          const bf16x8 x2 = *(const LAS bf16x8*)(lds + wk0 + (jj + 1) * 8192 + 2048), x3 = *(const LAS bf16x8*)(lds + wk1 + (jj + 1) * 8192 + 2048);
          if (jj & 1) { fa[0] = x0; fa[1] = x1; fa[2] = x2; fa[3] = x3; } else { fb[0] = x0; fb[1] = x1; fb[2] = x2; fb[3] = x3; }
          #pragma unroll
          for (int i = 0; i < 4; ++i) { const float t = bl[(jj + 1) * 64 + boff[i]]; if (jj & 1) ba[i] = t; else bb[i] = t; }
        }
        __builtin_amdgcn_sched_barrier(0);
        f32x4 a0 = {0.f, 0.f, 0.f, 0.f}, a1 = {0.f, 0.f, 0.f, 0.f};
        a0 = __builtin_amdgcn_mfma_f32_16x16x32_bf16((jj & 1) ? fb[0] : fa[0], qf0, a0, 0, 0, 0);
        a0 = __builtin_amdgcn_mfma_f32_16x16x32_bf16((jj & 1) ? fb[1] : fa[1], qf1, a0, 0, 0, 0);
        a1 = __builtin_amdgcn_mfma_f32_16x16x32_bf16((jj & 1) ? fb[2] : fa[2], qf0, a1, 0, 0, 0);
        a1 = __builtin_amdgcn_mfma_f32_16x16x32_bf16((jj & 1) ? fb[3] : fa[3], qf1, a1, 0, 0, 0);
        f32x4 a;
        #pragma unroll
        for (int i = 0; i < 4; ++i) {
          const float bias = (jj & 1) ? bb[i] : ba[i];
          a[i] = (vm[i] ? a0[i] : a1[i]) * SC2 + bias;
          mxw = fmaxf(mxw, a[i]);
        }
        sw[jj] = a;
        __builtin_amdgcn_sched_barrier(0);
      }
      mxw = fmaxf(mxw, __shfl_xor(mxw, 16));
      mxw = fmaxf(mxw, __shfl_xor(mxw, 32));
      mw = mxw;
      #pragma unroll
      for (int jj = 0; jj < 8; ++jj) {
        float e0[4], e1[4];
        #pragma unroll
        for (int i = 0; i < 4; ++i) {
          const float e = fexp2(sw[jj][i] - mw);
          lw += e;
          e0[i] = vm[i] ? e : 0.f; e1[i] = vm[i] ? 0.f : e;
        }
        u32x4 bu; bu[0] = pk2(e0[0], e0[1]); bu[1] = pk2(e0[2], e0[3]); bu[2] = pk2(e1[0], e1[1]); bu[3] = pk2(e1[2], e1[3]);
        pw[jj] = __builtin_bit_cast(bf16x8, bu);
      }
    } else {
      #pragma unroll
      for (int jj = 0; jj < 8; ++jj) pw[jj] = (bf16x8){0, 0, 0, 0, 0, 0, 0, 0};
    }
    lc += __shfl_xor(lc, 16); lc += __shfl_xor(lc, 32);
    lw += __shfl_xor(lw, 16); lw += __shfl_xor(lw, 32);
    const float mfin = fmaxf(mc, mw);
    const float fc = fexp2(mc - mfin), fw = fexp2(mw - mfin);
    const float inv = __builtin_amdgcn_rcpf(lc * fc + lw * fw);
    const float gc = fc * inv, gw = fw * inv;

    __syncthreads();
    store_img(cur);
    const int ntask = task + G;
    const bool has_next = (ntask < n_attn) && (round + 1 < r_end);
    AttnTask nxt = cur;
    if (has_next) { nxt = attn_decode(ntask); load_img(nxt, Z_K + nxt.h * 64); load_bias(nxt); }
    __syncthreads();

    uint2 gv[4];
    #pragma unroll
    for (int mbk = 0; mbk < 4; ++mbk) gv[mbk] = ld8_nt(z + qtok * ZC + Z_NG + h * 64 + 16 * mbk + 4 * fq);
    f32x4 oc[4], ow[4];
    #pragma unroll
    for (int mbk = 0; mbk < 4; ++mbk) { f32x4 zz = {0.f, 0.f, 0.f, 0.f}; oc[mbk] = zz; ow[mbk] = zz; }
    {
      s16x4 r3[3][8];
      #pragma unroll
      for (int p = 0; p < 2; ++p)
      #pragma unroll
        for (int mbk = 0; mbk < 4; ++mbk) {
          r3[p][2 * mbk]     = __builtin_amdgcn_ds_read_tr16_b64_v4i16((lds_s16x4_p)(lds + 73728 + tl[mbk] + p * 4096));
          r3[p][2 * mbk + 1] = __builtin_amdgcn_ds_read_tr16_b64_v4i16((lds_s16x4_p)(lds + 73728 + tl[mbk] + p * 4096 + 2048));
        }
      #pragma unroll
      for (int jj = 0; jj < 8; ++jj) {
        if (jj + 2 < 8) {
          #pragma unroll
          for (int mbk = 0; mbk < 4; ++mbk) {
            r3[(jj + 2) % 3][2 * mbk]     = __builtin_amdgcn_ds_read_tr16_b64_v4i16((lds_s16x4_p)(lds + 73728 + tl[mbk] + (jj + 2) * 4096));
            r3[(jj + 2) % 3][2 * mbk + 1] = __builtin_amdgcn_ds_read_tr16_b64_v4i16((lds_s16x4_p)(lds + 73728 + tl[mbk] + (jj + 2) * 4096 + 2048));
          }
        }
        __builtin_amdgcn_sched_barrier(0);
        #pragma unroll
        for (int mbk = 0; mbk < 4; ++mbk) {
          const bf16x8 av = __builtin_shufflevector(r3[jj % 3][2 * mbk], r3[jj % 3][2 * mbk + 1], 0, 1, 2, 3, 4, 5, 6, 7);
          oc[mbk] = __builtin_amdgcn_mfma_f32_16x16x32_bf16(av, pc[jj], oc[mbk], 0, 0, 0);
        }
        __builtin_amdgcn_sched_barrier(0);
      }
    }
    if (cur.lat) {
      s16x4 r3[3][8];
      const int tw = wb;
      #pragma unroll
      for (int p = 0; p < 2; ++p)
      #pragma unroll
        for (int mbk = 0; mbk < 4; ++mbk) {
          const int ta = tw + (tl[mbk] ^ pbx) + p * 8192;
          r3[p][2 * mbk]     = __builtin_amdgcn_ds_read_tr16_b64_v4i16((lds_s16x4_p)(lds + ta));
          r3[p][2 * mbk + 1] = __builtin_amdgcn_ds_read_tr16_b64_v4i16((lds_s16x4_p)(lds + ta + 2048));
        }
      #pragma unroll
      for (int jj = 0; jj < 8; ++jj) {
        if (jj + 2 < 8) {
          #pragma unroll
          for (int mbk = 0; mbk < 4; ++mbk) {
            const int ta = tw + (tl[mbk] ^ pbx) + (jj + 2) * 8192;
            r3[(jj + 2) % 3][2 * mbk]     = __builtin_amdgcn_ds_read_tr16_b64_v4i16((lds_s16x4_p)(lds + ta));
            r3[(jj + 2) % 3][2 * mbk + 1] = __builtin_amdgcn_ds_read_tr16_b64_v4i16((lds_s16x4_p)(lds + ta + 2048));
          }
        }
        __builtin_amdgcn_sched_barrier(0);
        #pragma unroll
        for (int mbk = 0; mbk < 4; ++mbk) {
          const bf16x8 av = __builtin_shufflevector(r3[jj % 3][2 * mbk], r3[jj % 3][2 * mbk + 1], 0, 1, 2, 3, 4, 5, 6, 7);
          ow[mbk] = __builtin_amdgcn_mfma_f32_16x16x32_bf16(av, pw[jj], ow[mbk], 0, 0, 0);
        }
        __builtin_amdgcn_sched_barrier(0);
      }
    }
    #pragma unroll
    for (int mbk = 0; mbk < 4; ++mbk) {
      const int dh = 16 * mbk + 4 * fq;
      const float g0 = bflo(gv[mbk].x), g1 = bfhi(gv[mbk].x), g2 = bflo(gv[mbk].y), g3 = bfhi(gv[mbk].y);
      const float o0 = oc[mbk][0] * gc + ow[mbk][0] * gw, o1 = oc[mbk][1] * gc + ow[mbk][1] * gw;
      const float o2 = oc[mbk][2] * gc + ow[mbk][2] * gw, o3 = oc[mbk][3] * gc + ow[mbk][3] * gw;
      uint2 ov; ov.x = pk2(o0 * g0, o1 * g1); ov.y = pk2(o2 * g2, o3 * g3);
      *(uint2*)(mb + qtok * D + 256 + h * 64 + dh) = ov;
    }
    __syncthreads();
    if (!has_next) break;
    cur = nxt; task = ntask; ++round;
  }
  __builtin_amdgcn_s_setprio(0);
}

struct ConvTask { int L, t0; size_t tokbase; };
DI ConvTask conv_decode(int task) {
  ConvTask t;
  if (task < 1024) { const int b = task >> 6; t.t0 = (task & 63) * 64; t.L = SEQ; t.tokbase = (size_t)b * SEQ; }
  else { const int t2 = task - 1024; const int b = t2 >> 2; t.t0 = (t2 & 3) * 64; t.L = NCTX; t.tokbase = (size_t)ML + b * NCTX; }
  return t;
}

DI void conv_loop(const Params& P, int wv, int l, int n_conv, int first, char* lds, int max_iters) {
  const u16* z = (const u16*)(P.ws + WS_Z);
  u16* mb = (u16*)(P.ws + WS_HM);
  const int tid = opaque_tid(wv);
  const int G = gridDim.x;
  int task = first, iters = 1;
  if (task >= n_conv) return;
  u16* U = (u16*)lds;
  float* O = (float*)(lds + 49152);

  uint4 pv[6];
  auto load_pq = [&](const ConvTask& t, int tq_) __attribute__((always_inline)) {
    #pragma unroll
    for (int it = 0; it < 6; ++it) {
      const int id = tq_ + it * 512, trow = id >> 5, cgA = id & 31;
      const int tt = t.t0 - 15 + trow;
      const bool ok = (id < 94 * 32) && tt >= 0 && tt < t.L;
      const u16* zr = z + (t.tokbase + (ok ? tt : t.t0)) * ZC;
      pv[it] = ld16_nt(zr + Z_CFU + cgA * 8);
    }
  };
  ConvTask cur = conv_decode(task);
  load_pq(cur, tid);

  for (;;) {
    const int L = cur.L, t0 = cur.t0; const size_t tokbase = cur.tokbase;
    int lq = l, tq = tid;
    asm volatile("" : "+s"(lq), "+v"(tq));
    const int c = tq & 255, run = tq >> 8;
    const int cg8 = tq & 31, srun = tq >> 5;
    const int lane = tq & 63, w = tq >> 6;
    #pragma unroll
    for (int it = 0; it < 6; ++it) {
      const int id = tq + it * 512, trow = id >> 5, cgA = id & 31;
      const int tt = t0 - 15 + trow;
      const bool ok = tt >= 0 && tt < L;
      if (id < 94 * 32) {
        uint4 o = pv[it];
        if (!ok) o = make_uint4(0u, 0u, 0u, 0u);
        *(uint4*)(U + trow * 256 + cgA * 8) = o;
      }
    }
    {
    uint4 hv[6], bv[4];
    #pragma unroll
    for (int jj = 0; jj < 6; ++jj) {
      const int tt = t0 + srun * 4 - 1 + jj;
      const bool ok = tt >= 0 && tt < L;
      const u16* zr = z + (tokbase + (ok ? tt : t0)) * ZC;
      hv[jj] = ld16_nt(zr + Z_SCV + cg8 * 8);
    }
    #pragma unroll
    for (int i = 0; i < 4; ++i) {
      const u16* zr = z + (tokbase + t0 + srun * 4 + i) * ZC;
      bv[i] = ld16_nt(zr + Z_SCG + cg8 * 8);
    }
      const float* wsc = P.conv_sc + (size_t)lq * 3 * 256 + cg8 * 8;
      float w0[8], w1[8], w2[8];
      #pragma unroll
      for (int e = 0; e < 8; ++e) { w0[e] = wsc[e]; w1[e] = wsc[256 + e]; w2[e] = wsc[512 + e]; }
      float v[6][8];
      #pragma unroll
      for (int jj = 0; jj < 6; ++jj) {
        const int tt = t0 + srun * 4 - 1 + jj;
        const bool ok = tt >= 0 && tt < L;
        float hf[8]; unpack8(hv[jj], hf);
        #pragma unroll
        for (int e = 0; e < 8; ++e) v[jj][e] = ok ? hf[e] : 0.f;
      }
      #pragma unroll
      for (int i = 0; i < 4; ++i) {
        const size_t tok = tokbase + t0 + srun * 4 + i;
        float bf[8], of[8]; unpack8(bv[i], bf);
        #pragma unroll
        for (int e = 0; e < 8; ++e)
          of[e] = bf[e] * (w0[e] * v[i][e] + w1[e] * v[i + 1][e] + w2[e] * v[i + 2][e]);
        uint4 ov; ov.x = pk2(of[0], of[1]); ov.y = pk2(of[2], of[3]); ov.z = pk2(of[4], of[5]); ov.w = pk2(of[6], of[7]);
        *(uint4*)(mb + tok * D + cg8 * 8) = ov;
      }
    }

    __syncthreads();

    const int ntask = task + G;
    const bool has_next = (ntask < n_conv) && (iters < max_iters);
    ConvTask nxt = cur;
    if (has_next) { nxt = conv_decode(ntask); load_pq(nxt, tq); }

    {
      const float* wcf = P.conv_cf + (size_t)lq * 31 * 256 + c;
      float wk[31];
      #pragma unroll
      for (int k = 0; k < 31; ++k) wk[k] = wcf[k * 256];
      f32x2 W2[32];
      #pragma unroll
      for (int k = 0; k < 32; ++k) { W2[k][0] = (k < 31) ? wk[k] : 0.f; W2[k][1] = (k > 0) ? wk[k - 1] : 0.f; }
      const float bias = P.conv_cf_b[lq * 256 + c];
      #pragma unroll 1
      for (int ob = 0; ob < 4; ++ob) {
        const int r0 = run * 32 + ob * 8;
        const u16* up = U + r0 * 256 + c;
        f32x2 acc2[4];
        #pragma unroll
        for (int p = 0; p < 4; ++p) { acc2[p][0] = bias; acc2[p][1] = bias; }
        unsigned short raw[38];
        #pragma unroll
        for (int jj = 0; jj < 38; ++jj) raw[jj] = up[jj * 256];
        __builtin_amdgcn_sched_barrier(0);
        #pragma unroll
        for (int jj = 0; jj < 38; ++jj) {
          const float val = __uint_as_float(((unsigned)raw[jj]) << 16);
          f32x2 v2; v2[0] = val; v2[1] = val;
          #pragma unroll
          for (int p = 0; p < 4; ++p) {
            if (jj - 2 * p >= 0 && jj - 2 * p <= 31) acc2[p] = W2[jj - 2 * p] * v2 + acc2[p];
          }
        }
        #pragma unroll
        for (int p = 0; p < 4; ++p) { O[(r0 + 2 * p) * 256 + c] = acc2[p][0]; O[(r0 + 2 * p + 1) * 256 + c] = acc2[p][1]; }
      }
    }
    uint2 zg[8];
    #pragma unroll
    for (int i = 0; i < 8; ++i) zg[i] = ld8_nt(z + (tokbase + t0 + w * 8 + i) * ZC + Z_CFG + lane * 4);
    __syncthreads();

    {
      const float4 lg = *(const float4*)(P.ln_cf_g + lq * 256 + lane * 4);
      const float4 lb = *(const float4*)(P.ln_cf_b + lq * 256 + lane * 4);
      float4 xva[8];
      #pragma unroll
      for (int i = 0; i < 8; ++i) xva[i] = *(const float4*)(O + (w * 8 + i) * 256 + lane * 4);
      __builtin_amdgcn_sched_barrier(0);
      #pragma unroll
      for (int i = 0; i < 8; ++i) {
        const int ti = w * 8 + i;
        const float4 xv = xva[i];
        const float s = wave_sum(xv.x + xv.y + xv.z + xv.w);
        const float mu = s * (1.f / 256.f);
        float d0 = xv.x - mu, d1 = xv.y - mu, d2 = xv.z - mu, d3 = xv.w - mu;
        const float q = wave_sum(d0 * d0 + d1 * d1 + d2 * d2 + d3 * d3);
        const float rstd = rsqrtf(q * (1.f / 256.f) + 1e-5f);
        const size_t tok = tokbase + t0 + ti;
        float y0 = silu_f(d0 * rstd * lg.x + lb.x) * bflo(zg[i].x);
        float y1 = silu_f(d1 * rstd * lg.y + lb.y) * bfhi(zg[i].x);
        float y2 = silu_f(d2 * rstd * lg.z + lb.z) * bflo(zg[i].y);
        float y3 = silu_f(d3 * rstd * lg.w + lb.w) * bfhi(zg[i].y);
        uint2 ov; ov.x = pk2(y0, y1); ov.y = pk2(y2, y3);
        *(uint2*)(mb + tok * D + 768 + lane * 4) = ov;
      }
    }
    if (!has_next) break;
    cur = nxt; task = ntask; ++iters;
  }
  __syncthreads();
}

DI void phase_mixer(const Params& P, int wv, int l, char* lds, int which = 3) {
  const bool last = (l == DEPTH - 1);
  const int n_attn = last ? 4096 : 4352;
  const int n_conv = last ? 1024 : 1088;
  const int G = gridDim.x;
  const int nr = (n_attn + G - 1) / G;
  const int L = logical_block();
  int l2 = l;
  asm volatile("" : "+s"(l2));
  if (which & 1) attn_loop(P, wv, l2, n_attn, lds, 0, nr);
  asm volatile("" : "+s"(l2));
  if (which & 2) conv_loop(P, wv, l2, n_conv, L, lds, 1000);
}

#define XB_TMO      128
#define XB_XCNT(j)  (256  + 64 * (j))
#define XB_XSUB(j)  (1280 + 64 * (j))
#define XB_XGEN(j)  (2304 + 64 * (j))
#define XB_TOP      3328
#define XB_TOPGEN   3392
#define XCD_BAR_WORDS 3456
#define XB_SPIN_CAP (1u << 18)
DI unsigned xb_ld(unsigned* p)              { return __hip_atomic_load(p, __ATOMIC_RELAXED, __HIP_MEMORY_SCOPE_AGENT); }
DI unsigned xb_add(unsigned* p, unsigned v) { return __hip_atomic_fetch_add(p, v, __ATOMIC_RELAXED, __HIP_MEMORY_SCOPE_AGENT); }
DI unsigned xb_xcc_id() { return (unsigned)__builtin_amdgcn_s_getreg((3 << 11) | 20) & 0xFu; }
#define XB_SPIN(cond, bar) do { unsigned _sp = 0; while (cond) { __builtin_amdgcn_s_sleep(1); \
    if ((++_sp & 255u) == 0u) { if (xb_ld(&(bar)[XB_TMO])) break; if (_sp > XB_SPIN_CAP) { atomicAdd(&(bar)[XB_TMO], 1u); break; } } } } while (0)
struct XcdBarrier { unsigned* bar; unsigned x; volatile LAS unsigned* st; };
DI XcdBarrier xcd_barrier_post(unsigned* bar, volatile LAS unsigned* st) {
  XcdBarrier b; b.bar = bar; b.x = xb_xcc_id(); b.st = st;
  if (threadIdx.x == 0) (void)xb_add(&bar[XB_XCNT(b.x)], 1u);
  return b;
}
DI void xcd_barrier_complete(unsigned* bar, unsigned x, unsigned& nloc, unsigned& nx) {
  const unsigned G = gridDim.x * gridDim.y * gridDim.z;
  unsigned sum, cnt, mine, sp = 0u;
  for (;;) {
    sum = 0u; cnt = 0u; mine = 0u;
    #pragma unroll
    for (unsigned j = 0; j < 16; ++j) { const unsigned c = xb_ld(&bar[XB_XCNT(j)]); sum += c; cnt += (c > 0u) ? 1u : 0u; mine = (j == x) ? c : mine; }
    if (sum == G) break;
    __builtin_amdgcn_s_sleep(1);
    if ((++sp & 255u) == 0u) { if (xb_ld(&bar[XB_TMO])) break; if (sp > XB_SPIN_CAP) { atomicAdd(&bar[XB_TMO], 1u); break; } }
  }
  nloc = mine > 0u ? mine : 1u; nx = cnt > 0u ? cnt : 1u;
}
DI void xcd_barrier(const XcdBarrier& b) {
  asm volatile("s_waitcnt vmcnt(0)" ::: "memory");
  __syncthreads();
  if (threadIdx.x == 0) {
    unsigned* bar = b.bar;
    __builtin_amdgcn_s_waitcnt(0);
    unsigned nloc = b.st[0], nx = b.st[1];
    if (nloc == 0u) { xcd_barrier_complete(bar, b.x, nloc, nx); b.st[0] = nloc; b.st[1] = nx; }
    const unsigned old = xb_add(&bar[XB_XSUB(b.x)], 1u);
    const unsigned gen = old / nloc;
    if (old + 1u == (gen + 1u) * nloc) {
      __builtin_amdgcn_fence(__ATOMIC_RELEASE, "agent");
      asm volatile("s_waitcnt vmcnt(0)" ::: "memory");
      const unsigned og = xb_add(&bar[XB_TOP], 1u);
      const unsigned tg = og / nx;
      if (og + 1u == (tg + 1u) * nx) xb_add(&bar[XB_TOPGEN], 1u);
      else XB_SPIN(xb_ld(&bar[XB_TOPGEN]) == tg, bar);
      __builtin_amdgcn_fence(__ATOMIC_ACQUIRE, "agent");
      xb_add(&bar[XB_XGEN(b.x)], 1u);
      asm volatile("s_waitcnt vmcnt(0)" ::: "memory");
    } else {
      XB_SPIN(xb_ld(&bar[XB_XGEN(b.x)]) == gen, bar);
      __builtin_amdgcn_fence(__ATOMIC_ACQUIRE, "agent");
      asm volatile("s_waitcnt vmcnt(0)" ::: "memory");
    }
  }
  __syncthreads();
}

constexpr int NPHASE = 18;
template <bool COOP>
__global__ void __launch_bounds__(512) mk_kernel(Params P, int ph_lo, int ph_hi) {
  extern __shared__ __attribute__((aligned(16))) char lds[];
  const int wv = __builtin_amdgcn_readfirstlane((int)(threadIdx.x >> 6));
  XcdBarrier xb;
  if (COOP) {
    volatile LAS unsigned* st = (volatile LAS unsigned*)((LAS char*)lds + LDS_WORK);
    if (threadIdx.x == 0) { st[0] = 0u; st[1] = 0u; }
    __syncthreads();
    xb = xcd_barrier_post((unsigned*)(P.ws + WS_BAR), st);
  }
  for (int ph = ph_lo; ph < ph_hi; ++ph) {
    if (ph == 0) phase0(P, wv, lds);
    else if (ph == NPHASE - 1) phase_resnorm(P, wv, DEPTH);
    else {
      const int l = (ph - 1) >> 2, s = (ph - 1) & 3;
      if (s == 0) { phase_resnorm(P, wv, l); }
      else if (s == 1) { phase_inproj(P, wv, l, lds); if (PROBE == 2) { cg::this_grid().sync(); phase_inproj(P, wv, l, lds); } }
      else if (s == 2) { phase_mixer(P, wv, l, lds); if (PROBE == 4) { cg::this_grid().sync(); phase_mixer(P, wv, l, lds, 1); } if (PROBE == 5) { cg::this_grid().sync(); phase_mixer(P, wv, l, lds, 2); } }
      else { phase_outproj(P, wv, l, lds); if (PROBE == 6) { cg::this_grid().sync(); phase_outproj(P, wv, l, lds); } }
    }
    if (COOP) { if (ph + 1 < ph_hi) {
      if (ph_hi > NPHASE) cg::this_grid().sync(); else xcd_barrier(xb);
    } }
  }
}

extern "C" void kernel_launch(void* const* d_in, const int* in_sizes, int n_in, void* d_out, int out_size,
                              void* d_ws, size_t ws_size, hipStream_t stream) {
  static int grid = 0;
  if (grid == 0) {
    if (n_in != 16 || out_size != ML * D || ws_size < WS_END) {
      fprintf(stderr, "kernel_launch: unexpected shapes n_in %d out %d ws %zu (need %zu)\n", n_in, out_size, ws_size, (size_t)WS_END);
      grid = -1; return;
    }
    int dev = 0, cus = 0, per_cu = 0;
    hipGetDevice(&dev);
    hipDeviceGetAttribute(&cus, hipDeviceAttributeMultiprocessorCount, dev);
    const void* fn = MK_COOP ? (const void*)mk_kernel<true> : (const void*)mk_kernel<false>;
    if (hipFuncSetAttribute(fn, hipFuncAttributeMaxDynamicSharedMemorySize, LDS_BYTES) != hipSuccess) {
      fprintf(stderr, "kernel_launch: hipFuncSetAttribute failed\n"); grid = -1; return;
    }
    if (hipOccupancyMaxActiveBlocksPerMultiprocessor(&per_cu, fn, 512, LDS_BYTES) != hipSuccess || per_cu < 1) {
      fprintf(stderr, "kernel_launch: occupancy query gave %d\n", per_cu); per_cu = 1;
    }
    (void)hipGetLastError();
    grid = cus * 1;
  }
  if (grid < 0) return;
  Params p{};
  p.x = (const float*)d_in[0]; p.c = (const float*)d_in[1]; p.ctx = (const float*)d_in[2]; p.c_ctx = (const float*)d_in[3];
  p.norm_g = (const float*)d_in[4]; p.w_ada = (const float*)d_in[5]; p.b_ada = (const float*)d_in[6]; p.w_in = (const float*)d_in[7];
  p.conv_sc = (const float*)d_in[8]; p.rpb = (const float*)d_in[9]; p.conv_cf = (const float*)d_in[10]; p.conv_cf_b = (const float*)d_in[11];
  p.ln_cf_g = (const float*)d_in[12]; p.ln_cf_b = (const float*)d_in[13]; p.w_out = (const float*)d_in[14]; p.final_g = (const float*)d_in[15];
  p.out = (float*)d_out; p.ws = (unsigned char*)d_ws;
  hipMemsetAsync((char*)d_ws + WS_MOD, 0, MOD_BYTES + XCD_BAR_WORDS * 4, stream);
#if MK_COOP
  int lo = 0, hi = NPHASE;
  void* args[] = {&p, &lo, &hi};
  hipError_t e = hipLaunchCooperativeKernel((const void*)mk_kernel<true>, dim3(grid), dim3(512), args, LDS_BYTES, stream);
  if (e != hipSuccess) fprintf(stderr, "cooperative launch failed: %s (grid %d)\n", hipGetErrorString(e), grid);
#else
  for (int ph = 0; ph < NPHASE; ++ph)
    hipLaunchKernelGGL(mk_kernel<false>, dim3(grid), dim3(512), LDS_BYTES, stream, p, ph, ph + 1);
#endif
}
```
